# Optimizing an MI355X kernel written in HIP

```python
import jax, jax.numpy as jnp
from jax import lax
import numpy as np

D_MODEL = 1024
BATCH = 8
SEQ = 2048
DEPTH = 4
DEC_BATCH = 128
DEC_SEQ = 4
PAST_LEN = 16384
PAGE_SIZE = 128

N_META = 16
MIX_WIDTH = D_MODEL
HG_WIDTH = MIX_WIDTH // 2
HG_HEADS = 4
HG_DK = HG_WIDTH // HG_HEADS
HG_DV = HG_WIDTH // HG_HEADS
POOL_WIDTH = MIX_WIDTH - HG_WIDTH
POOL_WINDOWS = (2, 4, 8, 16)
POOL_GROUPS = len(POOL_WINDOWS)
POOL_GC = POOL_WIDTH // POOL_GROUPS
POOL_STATE = max(POOL_WINDOWS) - 1
IN_COLS = 4 * HG_WIDTH + POOL_WIDTH
D_FF = ((8 * D_MODEL // 3 + 127) // 128) * 128
CHUNK = 64
EPS = 1e-6

kernel_name = "hgrn2_pool_macaron_hybrid_step"


def rmsnorm(x, gain):
    xf = x.astype(jnp.float32)
    y = xf * lax.rsqrt(jnp.mean(xf * xf, axis=-1, keepdims=True) + EPS)
    return (y * gain.astype(jnp.float32)).astype(x.dtype)


def swiglu(h, w_in, w_out):
    gate, up = jnp.split(h @ w_in, 2, axis=-1)
    return (jax.nn.silu(gate) * up) @ w_out


def layer_lower_bounds(lb_logits):
    p = jax.nn.softmax(lb_logits.astype(jnp.float32), axis=0)
    cs = jnp.cumsum(p, axis=0)
    return cs - cs[0:1]


def hgrn_chunk(S, q, k, v, g):
    L = q.shape[2]
    b = jnp.cumsum(g, axis=2)
    causal = jnp.tril(jnp.ones((L, L), dtype=bool))
    diff = b[:, :, :, None, :] - b[:, :, None, :, :]
    decay = jnp.exp(jnp.where(causal[None, None, :, :, None], diff, -jnp.inf))
    scores = jnp.einsum('bhtd,bhtsd,bhsd->bhts', q, decay, k)
    o = jnp.einsum('bhts,bhsv->bhtv', scores, v) + jnp.einsum('bhtd,bhdv->bhtv', q * jnp.exp(b), S)
    b_last = b[:, :, -1:, :]
    S_new = jnp.exp(b_last[:, :, 0, :])[..., None] * S + jnp.einsum('bhsd,bhsv->bhdv', k * jnp.exp(b_last - b), v)
    return S_new, o


def hgrn_prompt(q, k, v, g):
    Bn, H, T, _ = q.shape
    S0 = jnp.zeros((Bn, H, HG_DK, HG_DV), jnp.float32)
    S1, o_meta = hgrn_chunk(S0, q[:, :, :N_META], k[:, :, :N_META], v[:, :, :N_META], g[:, :, :N_META])
    n_chunks = (T - N_META) // CHUNK

    def to_chunks(a):
        a = a[:, :, N_META:].reshape(Bn, H, n_chunks, CHUNK, a.shape[-1])
        return jnp.moveaxis(a, 2, 0)

    S_fin, o_rest = lax.scan(lambda S, xs: hgrn_chunk(S, *xs), S1,
                             (to_chunks(q), to_chunks(k), to_chunks(v), to_chunks(g)))
    o_rest = jnp.moveaxis(o_rest, 0, 2).reshape(Bn, H, T - N_META, HG_DV)
    return S_fin, jnp.concatenate([o_meta, o_rest], axis=2)


def multiscale_pool(u_ext, n_out, pool_w, pool_scale):
    Bn, T, C = u_ext.shape
    uf = u_ext.astype(jnp.float32)
    cs0 = jnp.concatenate([jnp.zeros((Bn, 1, C), jnp.float32), jnp.cumsum(uf, axis=1)], axis=1)
    idx = jnp.arange(1, T + 1, dtype=jnp.float32)
    means = []
    for gi, w in enumerate(POOL_WINDOWS):
        c = cs0[:, :, gi * POOL_GC:(gi + 1) * POOL_GC]
        shifted = jnp.concatenate([jnp.zeros((Bn, w, POOL_GC), jnp.float32), c[:, :T + 1 - w]], axis=1)
        count = jnp.minimum(jnp.float32(w), idx)
        means.append((c[:, 1:] - shifted[:, 1:]) / count[None, :, None])
    pooled = jnp.concatenate(means, axis=-1)[:, T - n_out:]
    d = (pooled - uf[:, T - n_out:]).reshape(Bn, n_out, POOL_GROUPS, POOL_GC)
    y = jnp.einsum('btgc,gcd->btgd', d, pool_w.astype(jnp.float32)).reshape(Bn, n_out, POOL_WIDTH)
    return y * pool_scale.astype(jnp.float32)


def token_mixing(h, lb, w_in, hg_norm, pool_w, pool_scale, w_out, hg_state, pool_prev):
    Bn, T, _ = h.shape
    z = h @ w_in
    zq = z[..., :HG_WIDTH].astype(jnp.float32)
    zf = z[..., HG_WIDTH:2 * HG_WIDTH].astype(jnp.float32)
    zi = z[..., 2 * HG_WIDTH:3 * HG_WIDTH].astype(jnp.float32)
    zg = z[..., 3 * HG_WIDTH:4 * HG_WIDTH].astype(jnp.float32)
    zp = z[..., 4 * HG_WIDTH:]

    def heads(a):
        return a.reshape(Bn, T, HG_HEADS, -1).transpose(0, 2, 1, 3)

    q = heads(jax.nn.silu(zq))
    k = heads((1.0 - lb) * jax.nn.sigmoid(-zf))
    g = heads(jnp.logaddexp(jnp.log(lb), jnp.log1p(-lb) + jax.nn.log_sigmoid(zf)))
    v = heads(zi)
    if hg_state is None:
        S_new, o = hgrn_prompt(q, k, v, g)
    else:
        S_new, o = hgrn_chunk(hg_state.astype(jnp.float32), q, k, v, g)
    o = o * lax.rsqrt(jnp.mean(o * o, axis=-1, keepdims=True) + EPS) * hg_norm.astype(jnp.float32)[None, :, None, :]
    o = o.transpose(0, 2, 1, 3).reshape(Bn, T, HG_WIDTH) * jax.nn.silu(zg)

    u_ext = zp if pool_prev is None else jnp.concatenate([pool_prev.astype(zp.dtype), zp], axis=1)
    p = multiscale_pool(u_ext, T, pool_w, pool_scale)
    mixed = jnp.concatenate([o.astype(h.dtype), p.astype(h.dtype)], axis=-1) @ w_out
    return mixed, S_new, u_ext[:, -POOL_STATE:]


def run_trunk(x, state_hgrn, state_pool, lbs, norm_ffn1, w_ffn1_in, w_ffn1_out, norm_mix, w_in, hg_norm,
              pool_w, pool_scale, w_out, norm_ffn2, w_ffn2_in, w_ffn2_out, norm_final):
    hg_states, pool_states = [], []
    for l in range(DEPTH):
        x = x + 0.5 * swiglu(rmsnorm(x, norm_ffn1[l]), w_ffn1_in[l], w_ffn1_out[l])
        m, S, u = token_mixing(rmsnorm(x, norm_mix[l]), lbs[l], w_in[l], hg_norm[l], pool_w[l], pool_scale[l],
                               w_out[l],
                               None if state_hgrn is None else state_hgrn[l],
                               None if state_pool is None else state_pool[l])
        x = x + m
        x = x + 0.5 * swiglu(rmsnorm(x, norm_ffn2[l]), w_ffn2_in[l], w_ffn2_out[l])
        hg_states.append(S)
        pool_states.append(u)
    return rmsnorm(x, norm_final), jnp.stack(hg_states), jnp.stack(pool_states)


def setup_inputs(seed: int = 0) -> dict:
    key = jax.random.key(seed)
    ks = jax.random.split(key, 20)
    f32 = jnp.float32
    nrm = lambda k, shape, scale: jax.random.normal(k, shape, f32) * scale
    return {
        'x_prompt': nrm(ks[0], (BATCH, SEQ, D_MODEL), 1.0),
        'x_sample': nrm(ks[1], (DEC_BATCH, DEC_SEQ, D_MODEL), 1.0),
        'state_hgrn': nrm(ks[2], (DEPTH, DEC_BATCH, HG_HEADS, HG_DK, HG_DV), 0.5),
        'state_pool': nrm(ks[3], (DEPTH, DEC_BATCH, POOL_STATE, POOL_WIDTH), 1.0),
        'meta': nrm(ks[4], (N_META, D_MODEL), 1.0),
        'lb_logits': nrm(ks[5], (DEPTH, HG_WIDTH), 0.5),
        'norm_ffn1': 1.0 + nrm(ks[6], (DEPTH, D_MODEL), 0.05),
        'w_ffn1_in': nrm(ks[7], (DEPTH, D_MODEL, 2 * D_FF), D_MODEL ** -0.5),
        'w_ffn1_out': nrm(ks[8], (DEPTH, D_FF, D_MODEL), D_FF ** -0.5),
        'norm_mix': 1.0 + nrm(ks[9], (DEPTH, D_MODEL), 0.05),
        'w_in': nrm(ks[10], (DEPTH, D_MODEL, IN_COLS), D_MODEL ** -0.5),
        'hg_norm': 1.0 + nrm(ks[11], (DEPTH, HG_HEADS, HG_DV), 0.05),
        'pool_w': nrm(ks[12], (DEPTH, POOL_GROUPS, POOL_GC, POOL_GC), POOL_GC ** -0.5),
        'pool_scale': 1.0 + nrm(ks[13], (DEPTH, POOL_WIDTH), 0.1),
        'w_out': nrm(ks[14], (DEPTH, MIX_WIDTH, D_MODEL), MIX_WIDTH ** -0.5),
        'norm_ffn2': 1.0 + nrm(ks[15], (DEPTH, D_MODEL), 0.05),
        'w_ffn2_in': nrm(ks[16], (DEPTH, D_MODEL, 2 * D_FF), D_MODEL ** -0.5),
        'w_ffn2_out': nrm(ks[17], (DEPTH, D_FF, D_MODEL), D_FF ** -0.5),
        'norm_final': 1.0 + nrm(ks[18], (D_MODEL,), 0.05),
    }


def reference(x_prompt, x_sample, state_hgrn, state_pool, meta, lb_logits, norm_ffn1, w_ffn1_in, w_ffn1_out,
              norm_mix, w_in, hg_norm, pool_w, pool_scale, w_out, norm_ffn2, w_ffn2_in, w_ffn2_out, norm_final):
    lbs = layer_lower_bounds(lb_logits)
    weights = (norm_ffn1, w_ffn1_in, w_ffn1_out, norm_mix, w_in, hg_norm, pool_w, pool_scale, w_out,
               norm_ffn2, w_ffn2_in, w_ffn2_out, norm_final)
    meta_b = jnp.broadcast_to(meta.astype(x_prompt.dtype)[None], (x_prompt.shape[0], N_META, D_MODEL))
    xp = jnp.concatenate([meta_b, x_prompt], axis=1)
    yp, hg_p, pool_p = run_trunk(xp, None, None, lbs, *weights)
    y_prompt = yp[:, N_META:]
    y_sample, hg_s, pool_s = run_trunk(x_sample, state_hgrn, state_pool, lbs, *weights)
    return (y_prompt, y_sample, hg_p, pool_p, hg_s, pool_s)
```

```cpp
#include <hip/hip_runtime.h>
#include <hip/hip_cooperative_groups.h>
#include <cstdio>
#include <cstdint>
namespace cg = cooperative_groups;

#ifndef ONE_LAUNCH
#define ONE_LAUNCH 1
#endif
#ifndef DBG_MASK
#define DBG_MASK 0
#endif
#ifndef DBG_NPH
#define DBG_NPH 37
#endif

#define LAS __attribute__((address_space(3)))
typedef unsigned short bf16_t;
typedef short bf16x8 __attribute__((ext_vector_type(8)));
typedef float f32x4 __attribute__((ext_vector_type(4)));
typedef unsigned u32x4 __attribute__((ext_vector_type(4)));
typedef unsigned u32x2 __attribute__((ext_vector_type(2)));

constexpr int D = 1024, NB = 8, SEQ = 2048, NMETA = 16, TP = SEQ + NMETA, DEPTH = 4, DBATCH = 128, DSEQ = 4;
constexpr int MP = NB * TP;
constexpr int MS = DBATCH * DSEQ;
constexpr int MT = MP + MS;
constexpr int MPAD = 17152;
constexpr int NH = 4, FF = 2816, FF2 = 5632, INC = 2560, PST = 15;
constexpr int NCH = 33;
constexpr int NHI = NB * NH * NCH;
constexpr float EPS = 1e-6f;

constexpr size_t O_YP = 0, O_YS = 16777216, O_HGP = 17301504, O_POOLP = 19398656, O_HGS = 19644416, O_POOLS = 53198848;

constexpr size_t WS_CTL = 0;
constexpr size_t WS_SS = 65536;
constexpr size_t SS_BYTES = (size_t)16 * MPAD * 4;
constexpr size_t ZERO_BYTES = 65536;
constexpr size_t WS_LB = 0x120000;
constexpr size_t WS_DEC = WS_LB + 65536;
constexpr size_t WS_W = 2u << 20;
constexpr size_t WSET_BYTES = 42074112;
constexpr size_t WS_X = WS_W + 2 * WSET_BYTES + 0;
constexpr size_t WS_XB = WS_X + (size_t)MPAD * D * 4;
constexpr size_t WS_MIX = WS_XB + (size_t)MPAD * D * 2;
constexpr size_t WS_HZ = WS_MIX + (size_t)MPAD * D * 2;
constexpr size_t HZ_BYTES = (size_t)MPAD * INC * 2 + (size_t)MPAD * 512 * 4;
constexpr size_t WS_CS = WS_HZ + HZ_BYTES;
constexpr size_t WS_SB = WS_CS + (size_t)NHI * 16384 * 4;
constexpr size_t WS_HS = WS_SB + (size_t)NHI * 16384 * 2;
constexpr size_t WS_END = WS_HS + (size_t)768 * FF * 2;
constexpr int MMAIN = 16384, NDED = 16, NPROD = 12;
constexpr size_t WO_1I = 0, WO_1O = 5767168, WO_IN = 8650752, WO_OUT = 11272192, WO_2I = 12320768, WO_2O = 18087936, WO_PW = 20971520;

constexpr int LDS_BYTES = 135168;
#ifndef DBG_REPM
#define DBG_REPM 0
#endif
#if DBG_REPM
constexpr int NK = 12;
__device__ const int KSEQ[NK] = {0, 1, 2, 3, 3, 4, 4, 5, 5, 6, 7, 8};
#else
constexpr int NK = 9;
__device__ const int KSEQ[NK] = {0, 1, 2, 3, 4, 5, 6, 7, 8};
#endif
constexpr int NPH = 3 + DEPTH * NK;

__device__ __forceinline__ unsigned f2bf(float f) { unsigned u = __builtin_bit_cast(unsigned, f); return (u + 0x7fffu + ((u >> 16) & 1u)) >> 16; }
__device__ __forceinline__ float bf2f(unsigned short h) { return __builtin_bit_cast(float, (unsigned)h << 16); }
typedef float f32x2_t __attribute__((ext_vector_type(2))); typedef __bf16 bf16x2_t __attribute__((ext_vector_type(2)));
__device__ __forceinline__ unsigned cvt_pk_bf16(float lo, float hi) { f32x2_t v = {lo, hi}; bf16x2_t b = __builtin_convertvector(v, bf16x2_t); return __builtin_bit_cast(unsigned, b); }
__device__ __forceinline__ float wave_sum(float v) {
#pragma unroll
    for (int o = 1; o < 64; o <<= 1) v += __shfl_xor(v, o);
    return v;
}
__device__ __forceinline__ float row_rstd(const float* ssp, int row) {
    const f32x4* p = (const f32x4*)(ssp + (size_t)row * 16); const f32x4 a = p[0], b = p[1], c = p[2], d = p[3];
    const float s = (((a[0] + a[1]) + (a[2] + a[3])) + ((b[0] + b[1]) + (b[2] + b[3]))) + (((c[0] + c[1]) + (c[2] + c[3])) + ((d[0] + d[1]) + (d[2] + d[3])));
    return rsqrtf(s * (1.f / D) + EPS);
}
__device__ __forceinline__ float silu_f(float x) { return x * __builtin_amdgcn_rcpf(1.f + __expf(-x)); }
__device__ __forceinline__ f32x4 swiglu4(f32x4 g, f32x4 u) {
    const f32x4 gc = __builtin_elementwise_max(g, (f32x4){-40.f, -40.f, -40.f, -40.f});
    const f32x4 t = gc * (-1.4426950408889634f);
    f32x4 a; a[0] = __builtin_amdgcn_exp2f(t[0]); a[1] = __builtin_amdgcn_exp2f(t[1]); a[2] = __builtin_amdgcn_exp2f(t[2]); a[3] = __builtin_amdgcn_exp2f(t[3]);
    a = a + 1.0f;
    const float r01 = __builtin_amdgcn_rcpf(a[0] * a[1]), r23 = __builtin_amdgcn_rcpf(a[2] * a[3]);
    const f32x4 inv = (f32x4){a[1] * r01, a[0] * r01, a[3] * r23, a[2] * r23};
    return (gc * u) * inv;
}

namespace pg8 {
constexpr int BM = 256, BK = 64, HALF = 128, HTB = HALF * BK * 2, STAGE_BYTES = 8 * HTB, NXCD = 8, WGM = 8;
__host__ __device__ __forceinline__ int lds_byte(int r, int c) { const int st = (r >> 4) * 2 + (c >> 5), rr = r & 15, cc = c & 31, ob = rr * 64 + cc * 2; return st * 1024 + (ob ^ (((ob >> 9) & 1) << 5)); }
__host__ __device__ __forceinline__ void stage_rc(int b, int& R, int& C) { const int st = b / 1024, sb = b % 1024, swz = sb ^ (((sb >> 9) & 1) << 5); R = (st >> 1) * 16 + swz / 64; C = (st & 1) * 32 + (swz % 64) / 2; }
__host__ __device__ __forceinline__ int perm32(int rho) { const int n = rho >> 4, i = rho & 15; return 8 * (i >> 2) + 4 * n + (i & 3); }

struct Unit { int pm, pn; };
struct Gemm { const bf16_t* A; const bf16_t* Bt; int M, N, K, nt, koff; };
__device__ __forceinline__ Gemm mk_gemm(const bf16_t* A, const bf16_t* Bt, int M, int N, int K) { Gemm g; g.A = A; g.Bt = Bt; g.M = M; g.N = N; g.K = K; g.nt = K / 64; g.koff = 0; return g; }

struct StaticOrder {
    int nM, nN, nwg, G, c;
    __host__ __device__ void init(int M, int N, int G_, int c_) { nM = M / BM; nN = N / BM; nwg = nM * nN; G = G_; c = c_; }
    __host__ __device__ bool next(int i, Unit& u) const {
        const long L = (long)i * G + c; if (L >= nwg) return false;
        int wgid = (int)L; { const int q = nwg / NXCD, r = nwg % NXCD, xcd = wgid % NXCD, off = wgid / NXCD; wgid = (xcd < r ? xcd * (q + 1) : r * (q + 1) + (xcd - r) * q) + off; }
        const int nig = WGM * nN, gid = wgid / nig, fm = gid * WGM, gsz = (nM - fm) < WGM ? (nM - fm) : WGM;
        u.pm = fm + ((wgid % nig) % gsz); u.pn = (wgid % nig) / gsz; return true;
    }
    __device__ __forceinline__ void a_ready(const Unit&) const {}
    __device__ __forceinline__ void done(const Unit&) const {}
};

struct Order {
    StaticOrder so; int mode, nN, first, step, n;
    __device__ void init_static(int M, int N, int G_, int c_) { mode = 0; so.init(M, N, G_, c_); nN = 0; first = 0; step = 0; n = 0; }
    __device__ void init_list(int nN_, int first_, int step_, int n_) { mode = 1; so.init(256, 256, 1, 0); nN = nN_; first = first_; step = step_; n = n_; }
    __device__ bool next(int i, Unit& u) const {
        if (mode == 0) return so.next(i, u);
        if (i >= n) return false; const int L = first + i * step; u.pm = 64 + L / nN; u.pn = L - (L / nN) * nN; return true;
    }
    __device__ __forceinline__ void a_ready(const Unit&) const {}
    __device__ __forceinline__ void done(const Unit&) const {}
};


struct EpiSwiGLU {
    static constexpr bool PERM = true, AFTER_DRAIN = false;
    bf16_t* H; const float* ss;
    __device__ __forceinline__ void operator()(const f32x4 (&acc)[2][2][4][2], const Unit& u, int wr, int wc, int fr, int fq) const {
        const int row0 = u.pm * BM + wr * 64 + fr; const int col0 = u.pn * HALF + wc * 32 + 8 * fq;
#pragma unroll
        for (int ai = 0; ai < 2; ++ai)
#pragma unroll
            for (int m = 0; m < 4; ++m) {
                const int row = row0 + ai * HALF + m * 16;
                const float rstd = row_rstd(ss, row);
                const f32x4 g0 = acc[ai][0][m][0] * rstd, g1 = acc[ai][0][m][1] * rstd, u0 = acc[ai][1][m][0] * rstd, u1 = acc[ai][1][m][1] * rstd;
                u32x4 w;
                const f32x4 h0 = swiglu4(g0, u0), h1 = swiglu4(g1, u1);
                w.x = cvt_pk_bf16(h0[0], h0[1]); w.y = cvt_pk_bf16(h0[2], h0[3]);
                w.z = cvt_pk_bf16(h1[0], h1[1]); w.w = cvt_pk_bf16(h1[2], h1[3]);
                *(u32x4*)(H + (size_t)row * FF + col0) = w;
            }
    }
};

struct EpiResid {
    static constexpr bool PERM = false, AFTER_DRAIN = false;
    float* XS; bf16_t* XB; float* ssn; float c; int mode; unsigned* pcnt;
    static __device__ __forceinline__ float store_round(bf16_t* p, const f32x4 x) {
        u32x2 w; w.x = cvt_pk_bf16(x[0], x[1]); w.y = cvt_pk_bf16(x[2], x[3]);
        *(u32x2*)p = w;
        const float r0 = __builtin_bit_cast(float, w.x << 16), r1 = __builtin_bit_cast(float, w.x & 0xffff0000u), r2 = __builtin_bit_cast(float, w.y << 16), r3 = __builtin_bit_cast(float, w.y & 0xffff0000u);
        return (r0 * r0 + r1 * r1) + (r2 * r2 + r3 * r3);
    }
    __device__ __forceinline__ void operator()(const f32x4 (&acc)[2][2][4][2], const Unit& u, int wr, int wc, int fr, int fq) const {
        const int row0 = u.pm * BM + wr * 64 + fr; const int col0 = u.pn * BM + wc * 32 + 4 * fq;
        float* xs = XS + (size_t)(u.pn + 4 * (u.pm - 64)) * 65536 + (wr * 64 + fr) * 256 + wc * 32 + 4 * fq;
        if (mode == 2) { unsigned sp = 0; while (__hip_atomic_load(pcnt, __ATOMIC_RELAXED, __HIP_MEMORY_SCOPE_AGENT) < 1u) { __builtin_amdgcn_s_sleep(2); if (++sp > (1u << 24)) break; }
            __builtin_amdgcn_fence(__ATOMIC_ACQUIRE, "agent"); asm volatile("s_waitcnt vmcnt(0)" ::: "memory"); }
        if (mode == 2) {
#pragma unroll
            for (int aim = 0; aim < 4; ++aim) { const int ai = aim >> 1, m0 = (aim & 1) * 2;
                f32x4 xv[2][2][2];
#pragma unroll
                for (int mm = 0; mm < 2; ++mm)
#pragma unroll
                    for (int bj = 0; bj < 2; ++bj)
#pragma unroll
                        for (int n = 0; n < 2; ++n) xv[mm][bj][n] = *(const f32x4*)(xs + (ai * HALF + (m0 + mm) * 16) * 256 + bj * HALF + n * 16);
#pragma unroll
                for (int mm = 0; mm < 2; ++mm) { const int m = m0 + mm; const int row = row0 + ai * HALF + m * 16; bf16_t* xb = XB + (size_t)row * D + col0; float q = 0.f;
#pragma unroll
                    for (int bj = 0; bj < 2; ++bj)
#pragma unroll
                        for (int n = 0; n < 2; ++n) { const f32x4 x = xv[mm][bj][n] + acc[ai][bj][m][n] * c; q += store_round(xb + bj * HALF + n * 16, x); }
                    q += __shfl_xor(q, 16); q += __shfl_xor(q, 32);
                    if (fq == 0) ssn[(size_t)row * 16 + u.pn * 4 + wc] = q; }
                asm volatile("" ::: "memory");
            }
        } else {
#pragma unroll
            for (int ai = 0; ai < 2; ++ai) {
                u32x2 raw[4][2][2];
#pragma unroll
                for (int m = 0; m < 4; ++m) { const bf16_t* xb = XB + (size_t)(row0 + ai * HALF + m * 16) * D + col0;
#pragma unroll
                    for (int bj = 0; bj < 2; ++bj)
#pragma unroll
                        for (int n = 0; n < 2; ++n) raw[m][bj][n] = *(const u32x2*)(xb + bj * HALF + n * 16); }
#pragma unroll
                for (int m = 0; m < 4; ++m) { const int row = row0 + ai * HALF + m * 16; bf16_t* xb = XB + (size_t)row * D + col0; float q = 0.f;
#pragma unroll
                    for (int bj = 0; bj < 2; ++bj)
#pragma unroll
                        for (int n = 0; n < 2; ++n) { const u32x2 w = raw[m][bj][n];
                            const f32x4 xo = (f32x4){__builtin_bit_cast(float, w.x << 16), __builtin_bit_cast(float, w.x & 0xffff0000u), __builtin_bit_cast(float, w.y << 16), __builtin_bit_cast(float, w.y & 0xffff0000u)};
                            const f32x4 x = xo + acc[ai][bj][m][n] * c;
                            if (mode == 1) *(f32x4*)(xs + (ai * HALF + m * 16) * 256 + bj * HALF + n * 16) = x;
                            else q += store_round(xb + bj * HALF + n * 16, x); }
                    q += __shfl_xor(q, 16); q += __shfl_xor(q, 32);
                    if (fq == 0 && mode != 1) ssn[(size_t)row * 16 + u.pn * 4 + wc] = q; }
                asm volatile("" ::: "memory");
            }
        }
    }
};

struct EpiMix {
    static constexpr bool PERM = true, AFTER_DRAIN = false;
    bf16_t* ZB; float* GB; const float* ss; const float* lb;
    __device__ __forceinline__ void operator()(const f32x4 (&acc)[2][2][4][2], const Unit& u, int wr, int wc, int fr, int fq) const {
        const int row0 = u.pm * BM + wr * 64 + fr; const int seg = u.pn >> 1; const int cs0 = (u.pn & 1) * BM + wc * 32 + 8 * fq;
        if (seg == 1) {
#pragma unroll
            for (int bj = 0; bj < 2; ++bj) {
                const int cs = cs0 + bj * HALF;
                const f32x4 l0 = *(const f32x4*)(lb + cs), l1 = *(const f32x4*)(lb + cs + 4);
#pragma unroll
                for (int ai = 0; ai < 2; ++ai)
#pragma unroll
                    for (int m = 0; m < 4; ++m) {
                        const int row = row0 + ai * HALF + m * 16;
                        const float rstd = row_rstd(ss, row);
                        float kk[8], gg[8];
#pragma unroll
                        for (int e = 0; e < 8; ++e) {
                            const float z = (e < 4 ? acc[ai][bj][m][0][e & 3] : acc[ai][bj][m][1][e & 3]) * rstd;
                            const float lbv = e < 4 ? l0[e & 3] : l1[e & 3];
                            const float e2 = __expf(-fabsf(z)); const float r = __builtin_amdgcn_rcpf(1.f + e2);
                            const float sp = z >= 0.f ? r : e2 * r;
                            const float sm = z >= 0.f ? e2 * r : r;
                            kk[e] = (1.f - lbv) * sm;
                            gg[e] = __logf(lbv + (1.f - lbv) * sp);
                        }
                        u32x4 w; w.x = cvt_pk_bf16(kk[0], kk[1]); w.y = cvt_pk_bf16(kk[2], kk[3]); w.z = cvt_pk_bf16(kk[4], kk[5]); w.w = cvt_pk_bf16(kk[6], kk[7]);
                        *(u32x4*)(ZB + (size_t)row * INC + 512 + cs) = w;
                        *(f32x4*)(GB + (size_t)row * 512 + cs) = (f32x4){gg[0], gg[1], gg[2], gg[3]};
                        *(f32x4*)(GB + (size_t)row * 512 + cs + 4) = (f32x4){gg[4], gg[5], gg[6], gg[7]};
                    }
            }
        } else {
            const bool act = (seg == 0) || (seg == 3);
#pragma unroll
            for (int ai = 0; ai < 2; ++ai)
#pragma unroll
                for (int m = 0; m < 4; ++m) {
                    const int row = row0 + ai * HALF + m * 16;
                    const float rstd = row_rstd(ss, row);
#pragma unroll
                    for (int bj = 0; bj < 2; ++bj) {
                        f32x4 z0 = acc[ai][bj][m][0] * rstd, z1 = acc[ai][bj][m][1] * rstd;
                        if (act) {
#pragma unroll
                            for (int e = 0; e < 4; ++e) { z0[e] = silu_f(z0[e]); z1[e] = silu_f(z1[e]); }
                        }
                        u32x4 w; w.x = cvt_pk_bf16(z0[0], z0[1]); w.y = cvt_pk_bf16(z0[2], z0[3]); w.z = cvt_pk_bf16(z1[0], z1[1]); w.w = cvt_pk_bf16(z1[2], z1[3]);
                        *(u32x4*)(ZB + (size_t)row * INC + seg * 512 + cs0 + bj * HALF) = w;
                    }
                }
        }
    }
};

template <class Epi, class Sched, bool ALIGN_EPI = false, bool SP2 = false>
__device__ __forceinline__ void gemm_phase(LAS unsigned char* lds, const Gemm g, const Sched& S, const Epi& E, const int tid) {
    const int wid = __builtin_amdgcn_readfirstlane(tid >> 6), lane = tid & 63, wr = wid >> 2, wc = wid & 3, fr = lane & 15, fq = lane >> 4;
    const int K = g.K, nt = g.nt;
    unsigned voffA[2], voffB[2];
#pragma unroll
    for (int i = 0; i < 2; ++i) { int R, C; stage_rc(tid * 16 + i * 8192, R, C); const int Rb = Epi::PERM ? ((R & ~31) + perm32(R & 31)) : R;
        voffA[i] = (unsigned)(R * K + C) * 2u; voffB[i] = (unsigned)(Rb * K + C) * 2u; }
    const size_t kstep = (size_t)(BK * 2);
    const size_t hstep = (size_t)HALF * K * 2;
    const size_t tstep = 2 * hstep;
    const unsigned ldsw = (unsigned)wid * 1024u;
    const int aoff = lds_byte(wr * 64 + fr, fq * 8), boff = lds_byte(wc * 32 + fr, fq * 8);
#define PG8_SA(b, h) (((b) * 2 + (h)) * HTB)
#define PG8_SB(b, h) ((4 + (b) * 2 + (h)) * HTB)
#define PG8_STAGE(bufoff, gbase, voff) do { _Pragma("unroll") for (int _i = 0; _i < 2; ++_i) \
        __builtin_amdgcn_global_load_lds((const unsigned*)((const char*)(gbase) + (voff)[_i]), (LAS unsigned*)(lds + (bufoff) + ldsw + _i * 8192), 16, 0, 0); } while (0)
#define PG8_LDA(dst, b, h) do { _Pragma("unroll") for (int m = 0; m < 4; ++m) _Pragma("unroll") for (int k = 0; k < 2; ++k) dst[m][k] = *(const LAS bf16x8*)(lds + PG8_SA(b, h) + aoff + m * 2048 + k * 1024); } while (0)
#define PG8_LDB(dst, b, h) do { _Pragma("unroll") for (int n = 0; n < 2; ++n) _Pragma("unroll") for (int k = 0; k < 2; ++k) dst[n][k] = *(const LAS bf16x8*)(lds + PG8_SB(b, h) + boff + n * 2048 + k * 1024); } while (0)
#define PG8_MMA(ai, bj, At, Bt) do { __builtin_amdgcn_s_setprio(1); _Pragma("unroll") for (int m = 0; m < 4; ++m) _Pragma("unroll") for (int n = 0; n < 2; ++n) _Pragma("unroll") for (int k = 0; k < 2; ++k) \
        acc[ai][bj][m][n] = __builtin_amdgcn_mfma_f32_16x16x32_bf16(Bt[n][k], At[m][k], acc[ai][bj][m][n], 0, 0, 0); __builtin_amdgcn_s_setprio(0); } while (0)
#define PG8_WAIT_V(n) asm volatile("s_waitcnt vmcnt(" #n ")" ::: "memory")
#define PG8_WAIT_L(n) asm volatile("s_waitcnt lgkmcnt(" #n ")" ::: "memory")
#define PG8_BAR __builtin_amdgcn_s_barrier()
#define PG8_SCHED __builtin_amdgcn_sched_barrier(0)
    Unit cur, nxt; int ui = 0;
    if (!S.next(0, cur)) return;
    f32x4 acc[2][2][4][2];
#pragma unroll
    for (int a = 0; a < 2; ++a)
#pragma unroll
        for (int b = 0; b < 2; ++b)
#pragma unroll
            for (int m = 0; m < 4; ++m)
#pragma unroll
                for (int n = 0; n < 2; ++n) acc[a][b][m][n] = (f32x4){0.f, 0.f, 0.f, 0.f};
    bf16x8 At[4][2], B0[2][2], B1[2][2];
    const char* gA = (const char*)g.A + g.koff; const char* gB = (const char*)g.Bt + g.koff;
    const char* cA = gA + (size_t)cur.pm * tstep; const char* cB = gB + (size_t)cur.pn * tstep;
    S.a_ready(cur);
    if constexpr (SP2) {
        PG8_STAGE(PG8_SB(0, 0), cB, voffB); PG8_STAGE(PG8_SB(0, 1), cB + hstep, voffB); PG8_STAGE(PG8_SA(0, 0), cA, voffA); PG8_STAGE(PG8_SA(0, 1), cA + hstep, voffA);
        if (wr == 1) PG8_BAR;
        PG8_WAIT_V(2); PG8_BAR;
        PG8_STAGE(PG8_SB(1, 0), cB + kstep, voffB); PG8_STAGE(PG8_SA(1, 0), cA + kstep, voffA); PG8_STAGE(PG8_SB(1, 1), cB + hstep + kstep, voffB);
        PG8_WAIT_V(6); PG8_BAR;
    } else {
        PG8_STAGE(PG8_SB(0, 0), cB, voffB); PG8_STAGE(PG8_SA(0, 0), cA, voffA); PG8_STAGE(PG8_SB(0, 1), cB + hstep, voffB); PG8_STAGE(PG8_SA(0, 1), cA + hstep, voffA);
        if (wr == 1) PG8_BAR;
        PG8_WAIT_V(4); PG8_BAR;
        PG8_STAGE(PG8_SB(1, 0), cB + kstep, voffB); PG8_STAGE(PG8_SA(1, 0), cA + kstep, voffA); PG8_STAGE(PG8_SB(1, 1), cB + hstep + kstep, voffB);
        PG8_WAIT_V(6); PG8_BAR;
    }
    for (;;) {
        const bool has_next = S.next(ui + 1, nxt);
        const char* nA = has_next ? gA + (size_t)nxt.pm * tstep : cA; const char* nB = has_next ? gB + (size_t)nxt.pn * tstep : cB;
        for (int t = 0; t < nt; t += 2) {
            const bool last = (t == nt - 2);
            const char* a1 = cA + (size_t)(t + 1) * kstep;
            const char* a2 = last ? nA : cA + (size_t)(t + 2) * kstep; const char* b2 = last ? nB : cB + (size_t)(t + 2) * kstep;
            const char* a3 = a2 + kstep; const char* b3 = b2 + kstep;
            if (last && has_next) S.a_ready(nxt);
            if constexpr (SP2) {
            PG8_LDB(B0, 0, 0); PG8_LDB(B1, 0, 1); PG8_SCHED; PG8_LDA(At, 0, 0); PG8_STAGE(PG8_SA(1, 1), a1 + hstep, voffA);
            PG8_WAIT_V(8); PG8_WAIT_L(0); PG8_BAR; PG8_MMA(0, 0, At, B0); PG8_MMA(0, 1, At, B1); PG8_BAR; PG8_SCHED;
            PG8_LDA(At, 0, 1); PG8_STAGE(PG8_SB(0, 0), b2, voffB); PG8_STAGE(PG8_SB(0, 1), b2 + hstep, voffB); PG8_STAGE(PG8_SA(0, 0), a2, voffA);
            PG8_WAIT_V(8); PG8_WAIT_L(0); PG8_BAR; PG8_MMA(1, 0, At, B0); PG8_MMA(1, 1, At, B1); PG8_BAR; PG8_SCHED;
            PG8_LDB(B0, 1, 0); PG8_LDB(B1, 1, 1); PG8_SCHED; PG8_LDA(At, 1, 0); PG8_STAGE(PG8_SA(0, 1), a2 + hstep, voffA);
            PG8_WAIT_V(8); PG8_WAIT_L(0); PG8_BAR; PG8_MMA(0, 0, At, B0); PG8_MMA(0, 1, At, B1); PG8_BAR; PG8_SCHED;
            PG8_LDA(At, 1, 1); PG8_STAGE(PG8_SB(1, 0), b3, voffB); PG8_STAGE(PG8_SB(1, 1), b3 + hstep, voffB); PG8_STAGE(PG8_SA(1, 0), a3, voffA);
            PG8_WAIT_V(8); PG8_WAIT_L(0); PG8_BAR; PG8_MMA(1, 0, At, B0); PG8_MMA(1, 1, At, B1); PG8_BAR; PG8_SCHED;
            } else {
            PG8_LDB(B0, 0, 0); PG8_SCHED; PG8_LDA(At, 0, 0); PG8_STAGE(PG8_SA(1, 1), a1 + hstep, voffA);
            PG8_WAIT_L(8); PG8_BAR; PG8_WAIT_L(0); PG8_MMA(0, 0, At, B0); PG8_BAR; PG8_SCHED;
            PG8_LDB(B1, 0, 1); PG8_STAGE(PG8_SB(0, 0), b2, voffB);
            PG8_BAR; PG8_WAIT_L(0); PG8_MMA(0, 1, At, B1); PG8_BAR;
            PG8_LDA(At, 0, 1); PG8_STAGE(PG8_SA(0, 0), a2, voffA);
            PG8_BAR; PG8_WAIT_L(0); PG8_MMA(1, 0, At, B0); PG8_BAR; PG8_SCHED;
            PG8_STAGE(PG8_SB(0, 1), b2 + hstep, voffB);
            PG8_WAIT_V(6); PG8_BAR; PG8_MMA(1, 1, At, B1); PG8_BAR;
            PG8_LDB(B0, 1, 0); PG8_SCHED; PG8_LDA(At, 1, 0); PG8_STAGE(PG8_SA(0, 1), a2 + hstep, voffA);
            PG8_WAIT_L(8); PG8_BAR; PG8_WAIT_L(0); PG8_MMA(0, 0, At, B0); PG8_BAR; PG8_SCHED;
            PG8_LDB(B1, 1, 1); PG8_STAGE(PG8_SB(1, 0), b3, voffB);
            PG8_BAR; PG8_WAIT_L(0); PG8_MMA(0, 1, At, B1); PG8_BAR;
            PG8_LDA(At, 1, 1); PG8_STAGE(PG8_SA(1, 0), a3, voffA);
            PG8_BAR; PG8_WAIT_L(0); PG8_MMA(1, 0, At, B0); PG8_BAR; PG8_SCHED;
            PG8_STAGE(PG8_SB(1, 1), b3 + hstep, voffB);
            PG8_WAIT_V(6); PG8_BAR; PG8_MMA(1, 1, At, B1); PG8_BAR;
            }
        }
        if constexpr (ALIGN_EPI) { if (wr == 0) PG8_BAR; }
        if constexpr (!Epi::AFTER_DRAIN) { E(acc, cur, wr, wc, fr, fq); S.done(cur); }
        if (!has_next) break;
#pragma unroll
        for (int a = 0; a < 2; ++a)
#pragma unroll
            for (int b = 0; b < 2; ++b)
#pragma unroll
                for (int m = 0; m < 4; ++m)
#pragma unroll
                    for (int n = 0; n < 2; ++n) acc[a][b][m][n] = (f32x4){0.f, 0.f, 0.f, 0.f};
        cur = nxt; cA = nA; cB = nB; ++ui;
        if constexpr (ALIGN_EPI) { if (wr == 1) PG8_BAR; }
    }
    PG8_WAIT_V(0);
    if constexpr (!ALIGN_EPI) { if (wr == 0) PG8_BAR; }
    PG8_BAR;
#undef PG8_SA
#undef PG8_SB
#undef PG8_STAGE
#undef PG8_LDA
#undef PG8_LDB
#undef PG8_MMA
#undef PG8_WAIT_V
#undef PG8_WAIT_L
#undef PG8_BAR
#undef PG8_SCHED
}
}

#define XB_TMO      128
#define XB_XCNT(j)  (256  + 64 * (j))
#define XB_XSUB(j)  (1280 + 64 * (j))
#define XB_XGEN(j)  (2304 + 64 * (j))
#define XB_TOP      3328
#define XB_TOPGEN   3392
#define XCD_BAR_WORDS 3456
#define XB_SPIN_CAP (1u << 22)
__device__ __forceinline__ unsigned xb_ld(unsigned* p)              { return __hip_atomic_load(p, __ATOMIC_RELAXED, __HIP_MEMORY_SCOPE_AGENT); }
__device__ __forceinline__ unsigned xb_add(unsigned* p, unsigned v) { return __hip_atomic_fetch_add(p, v, __ATOMIC_RELAXED, __HIP_MEMORY_SCOPE_AGENT); }
__device__ __forceinline__ unsigned xb_xcc_id() { return (unsigned)__builtin_amdgcn_s_getreg((3 << 11) | 20) & 0xFu; }
#define XB_SPIN(cond, bar) do { unsigned _sp = 0; while (cond) { __builtin_amdgcn_s_sleep(1); \
    if ((++_sp & 255u) == 0u) { if (xb_ld(&(bar)[XB_TMO])) break; if (_sp > XB_SPIN_CAP) { atomicAdd(&(bar)[XB_TMO], 1u); break; } } } } while (0)
struct XcdBarrier { unsigned* bar; unsigned x; volatile LAS unsigned* st; };
__device__ __forceinline__ XcdBarrier xcd_barrier_post(unsigned* bar, volatile LAS unsigned* st) {
    XcdBarrier b; b.bar = bar; b.x = xb_xcc_id(); b.st = st;
    if (threadIdx.x == 0) (void)xb_add(&bar[XB_XCNT(b.x)], 1u);
    return b;
}
__device__ __forceinline__ void xcd_barrier_complete(unsigned* bar, unsigned x, unsigned& nloc, unsigned& nx) {
    const unsigned G = gridDim.x * gridDim.y * gridDim.z;
    unsigned sum, cnt, mine, sp = 0u;
    for (;;) {
        sum = 0u; cnt = 0u; mine = 0u;
#pragma unroll
        for (unsigned j = 0; j < 16; ++j) { const unsigned c = xb_ld(&bar[XB_XCNT(j)]); sum += c; cnt += (c > 0u) ? 1u : 0u; mine = (j == x) ? c : mine; }
        if (sum == G) break;
        __builtin_amdgcn_s_sleep(1);
        if ((++sp & 255u) == 0u) { if (xb_ld(&bar[XB_TMO])) break; if (sp > XB_SPIN_CAP) { atomicAdd(&bar[XB_TMO], 1u); break; } }
    }
    nloc = mine > 0u ? mine : 1u; nx = cnt > 0u ? cnt : 1u;
}
__device__ __forceinline__ void xcd_barrier(const XcdBarrier& b) {
    asm volatile("s_waitcnt vmcnt(0)" ::: "memory");
    __syncthreads();
    if (threadIdx.x == 0) {
        unsigned* bar = b.bar;
        __builtin_amdgcn_s_waitcnt(0);
        unsigned nloc = b.st[0], nx = b.st[1];
        if (nloc == 0u) { xcd_barrier_complete(bar, b.x, nloc, nx); b.st[0] = nloc; b.st[1] = nx; }
        const unsigned old = xb_add(&bar[XB_XSUB(b.x)], 1u);
        const unsigned gen = old / nloc;
        if (old + 1u == (gen + 1u) * nloc) {
            __builtin_amdgcn_fence(__ATOMIC_RELEASE, "agent");
            asm volatile("s_waitcnt vmcnt(0)" ::: "memory");
            const unsigned og = xb_add(&bar[XB_TOP], 1u);
            const unsigned tg = og / nx;
            if (og + 1u == (tg + 1u) * nx) xb_add(&bar[XB_TOPGEN], 1u);
            else XB_SPIN(xb_ld(&bar[XB_TOPGEN]) == tg, bar);
            __builtin_amdgcn_fence(__ATOMIC_ACQUIRE, "agent");
            xb_add(&bar[XB_XGEN(b.x)], 1u);
            asm volatile("s_waitcnt vmcnt(0)" ::: "memory");
        } else {
            XB_SPIN(xb_ld(&bar[XB_XGEN(b.x)]) == gen, bar);
            __builtin_amdgcn_fence(__ATOMIC_ACQUIRE, "agent");
            asm volatile("s_waitcnt vmcnt(0)" ::: "memory");
        }
    }
    __syncthreads();
}

__device__ __forceinline__ void handoff_publish(unsigned* cnt) {
    asm volatile("s_waitcnt vmcnt(0)" ::: "memory");
    __syncthreads();
    if (threadIdx.x == 0) {
        __builtin_amdgcn_fence(__ATOMIC_RELEASE, "agent");
        asm volatile("s_waitcnt vmcnt(0)" ::: "memory");
        (void)xb_add(cnt, 1u);
    }
}
__device__ __forceinline__ void handoff_wait(unsigned* cnt, unsigned target) {
    unsigned sp = 0;
    while (xb_ld(cnt) < target) { __builtin_amdgcn_s_sleep(4); if (++sp > (1u << 24)) break; }
    __builtin_amdgcn_fence(__ATOMIC_ACQUIRE, "agent");
    asm volatile("s_waitcnt vmcnt(0)" ::: "memory");
}

struct Args { const float* in[19]; float* out; unsigned char* ws; int ph_lo, ph_hi; };
typedef const __attribute__((address_space(4))) Args* ArgsP;
enum { I_XP = 0, I_XS, I_SHG, I_SPOOL, I_META, I_LBL, I_N1, I_W1I, I_W1O, I_NM, I_WIN, I_HGN, I_PW, I_PS, I_WOUT, I_N2, I_W2I, I_W2O, I_NF };

__device__ __forceinline__ void conv_item(const float* W, int ldw, const float* kscale, const float* nscale, bf16_t* WT, int ldt, int drow0, int k0, int n0, LAS float* scr, int lane) {
    float wv[32];
#pragma unroll
    for (int i = 0; i < 32; ++i) wv[i] = W[(size_t)(k0 + 2 * i + (lane >> 5)) * ldw + n0 + (lane & 31)];
    const float ns = nscale ? nscale[n0 + (lane & 31)] : 1.f;
    float ksv[2];
    ksv[0] = kscale ? kscale[k0 + lane] : 1.f;
#pragma unroll
    for (int i = 0; i < 32; ++i) {
        const int kk = 2 * i + (lane >> 5), n = lane & 31;
        const float kv = __builtin_bit_cast(float, __builtin_amdgcn_ds_bpermute(kk << 2, __builtin_bit_cast(int, ksv[0])));
        scr[kk * 33 + n] = wv[i] * kv * ns;
    }
    asm volatile("s_waitcnt lgkmcnt(0)" ::: "memory");
    const int c = lane & 7;
#pragma unroll
    for (int j = 0; j < 4; ++j) {
        const int n = (lane >> 3) + 8 * j; const LAS float* s = scr + (8 * c) * 33 + n;
        u32x4 o; o.x = cvt_pk_bf16(s[0 * 33], s[1 * 33]); o.y = cvt_pk_bf16(s[2 * 33], s[3 * 33]); o.z = cvt_pk_bf16(s[4 * 33], s[5 * 33]); o.w = cvt_pk_bf16(s[6 * 33], s[7 * 33]);
        *(u32x4*)(WT + (size_t)(drow0 + n) * ldt + k0 + 8 * c) = o;
    }
    asm volatile("s_waitcnt lgkmcnt(0)" ::: "memory");
}

__device__ __forceinline__ void wconv_layer(ArgsP a, int l, bf16_t* ws_set, LAS float* scr, int gw, int NGW, int lane) {
    constexpr int I1 = 16 * 176, I2 = 44 * 32, I3 = 16 * 80, I4 = 16 * 32, I7 = 32;
    for (int it = gw; it < 2 * I1 + 2 * I2 + I3 + I4 + I7; it += NGW) {
        int r = it; const float* W; const float* ks = nullptr; const float* ns = nullptr; bf16_t* WT; int K, N; int mode = 0;
        if (r < I1) { W = a->in[I_W1I] + (size_t)l * D * FF2; ks = a->in[I_N1] + l * D; WT = ws_set + WO_1I; K = D; N = FF2; mode = 1; }
        else if ((r -= I1) < I2) { W = a->in[I_W1O] + (size_t)l * FF * D; WT = ws_set + WO_1O; K = FF; N = D; }
        else if ((r -= I2) < I3) { W = a->in[I_WIN] + (size_t)l * D * INC; ks = a->in[I_NM] + l * D; WT = ws_set + WO_IN; K = D; N = INC; }
        else if ((r -= I3) < I4) { W = a->in[I_WOUT] + (size_t)l * D * D; WT = ws_set + WO_OUT; K = D; N = D; }
        else if ((r -= I4) < I1) { W = a->in[I_W2I] + (size_t)l * D * FF2; ks = a->in[I_N2] + l * D; WT = ws_set + WO_2I; K = D; N = FF2; mode = 1; }
        else if ((r -= I1) < I2) { W = a->in[I_W2O] + (size_t)l * FF * D; WT = ws_set + WO_2O; K = FF; N = D; }
        else { r -= I2; const int g = r >> 3; r &= 7; W = a->in[I_PW] + (size_t)(l * 4 + g) * 16384; ns = a->in[I_PS] + l * 512 + g * 128; WT = ws_set + WO_PW + g * 16384; K = 128; N = 128; }
        const int nblk = N / 32, kb = r / nblk, nb = r % nblk, k0 = 64 * kb, n0 = 32 * nb;
        int drow0 = n0;
        if (mode == 1) { if (n0 < FF) drow0 = (n0 / 128) * 256 + (n0 % 128); else { const int j = n0 - FF; drow0 = (j / 128) * 256 + 128 + (j % 128); } }
        conv_item(W, N, ks, ns, WT, K, drow0, k0, n0, scr, lane);
    }
}

typedef short v4i16_t __attribute__((ext_vector_type(4)));
__device__ __forceinline__ bf16x8 tr_frag(const LAS bf16_t* tile, int stride, int s0, int v0, int r, int q) {
    const LAS bf16_t* p0 = tile + (s0 + 8 * q + (r >> 2)) * stride + v0 + 4 * (r & 3);
    const v4i16_t lo = __builtin_amdgcn_ds_read_tr16_b64_v4i16((LAS v4i16_t*)p0);
    const v4i16_t hi = __builtin_amdgcn_ds_read_tr16_b64_v4i16((LAS v4i16_t*)(p0 + 4 * stride));
    return (bf16x8){lo[0], lo[1], lo[2], lo[3], hi[0], hi[1], hi[2], hi[3]};
}

struct ChunkGeo { int b, h, c, L; size_t r0; };
__device__ __forceinline__ int chunk_slot(int wi) { return wi < 1024 ? (wi >> 5) * NCH + 1 + (wi & 31) : (wi - 1024) * NCH; }
__device__ __forceinline__ ChunkGeo chunk_geo(int it) {
    ChunkGeo g; const int bh = it / NCH; g.c = it - bh * NCH; g.b = bh >> 2; g.h = bh & 3;
    const int t0 = g.c == 0 ? 0 : NMETA + 64 * (g.c - 1); g.L = g.c == 0 ? NMETA : 64; g.r0 = (size_t)g.b * TP + t0; return g;
}

__device__ __forceinline__ void hgrn_local_item(int it, const bf16_t* ZB, const float* GB, bf16_t* CS, float* DEC, LAS unsigned char* lds, int tid) {
    const ChunkGeo G = chunk_geo(it);
    const int d = tid & 127, p = tid >> 7, lane = tid & 63, w = tid >> 6, r = lane & 15, q = lane >> 4;
    LAS float* TOT = (LAS float*)lds;
    LAS bf16_t* KDT = (LAS bf16_t*)(lds + 2048);
    LAS bf16_t* VS = (LAS bf16_t*)(lds + 20480);
    const bool pv = (16 * p < G.L);
    float bb[16]; unsigned short kraw[16]; u32x4 vv[2];
    const int prow = pv ? 16 * p : 0;
#pragma unroll
    for (int i = 0; i < 16; ++i) bb[i] = GB[(G.r0 + prow + i) * 512 + G.h * 128 + d];
#pragma unroll
    for (int i = 0; i < 16; ++i) kraw[i] = ZB[(G.r0 + prow + i) * INC + 512 + G.h * 128 + d];
#pragma unroll
    for (int e2 = 0; e2 < 2; ++e2) { const int e = tid + 512 * e2, s = e >> 4, ch = e & 15; const int sc = s < G.L ? s : 0;
        vv[e2] = *(const u32x4*)(ZB + (G.r0 + sc) * INC + 1024 + G.h * 128 + ch * 8); }
#pragma unroll
    for (int i = 0; i < 16; ++i) { bb[i] = pv ? bb[i] : 0.f; kraw[i] = pv ? kraw[i] : (unsigned short)0; }
#pragma unroll
    for (int e2 = 0; e2 < 2; ++e2) { const int e = tid + 512 * e2, s = e >> 4; if (s >= G.L) vv[e2] = (u32x4){0u, 0u, 0u, 0u}; }
    float run = 0.f;
#pragma unroll
    for (int i = 0; i < 16; ++i) { run += bb[i]; bb[i] = run; }
    TOT[p * 128 + d] = run;
#pragma unroll
    for (int e2 = 0; e2 < 2; ++e2) { const int e = tid + 512 * e2, s = e >> 4, ch = e & 15; *(LAS u32x4*)(VS + s * 136 + ch * 8) = vv[e2]; }
    __syncthreads();
    float off = 0.f, tot = 0.f;
#pragma unroll
    for (int pp = 0; pp < 4; ++pp) { const float tv = TOT[pp * 128 + d]; if (pp < p) off += tv; tot += tv; }
    unsigned kd[8];
#pragma unroll
    for (int i = 0; i < 16; i += 2) {
        const float k0 = bf2f(kraw[i]), k1 = bf2f(kraw[i + 1]);
        kd[i >> 1] = cvt_pk_bf16(k0 * __expf(tot - (bb[i] + off)), k1 * __expf(tot - (bb[i + 1] + off)));
    }
    *(LAS u32x4*)(KDT + d * 72 + 16 * p) = (u32x4){kd[0], kd[1], kd[2], kd[3]};
    *(LAS u32x4*)(KDT + d * 72 + 16 * p + 8) = (u32x4){kd[4], kd[5], kd[6], kd[7]};
    if (p == 0) DEC[(size_t)it * 128 + d] = __expf(tot);
    __syncthreads();
    bf16x8 vf[2];
#pragma unroll
    for (int ks = 0; ks < 2; ++ks) vf[ks] = tr_frag(VS, 136, 32 * ks, 16 * w, r, q);
    bf16_t* cs = CS + (size_t)it * 16384;
#pragma unroll
    for (int dt = 0; dt < 8; ++dt) {
        f32x4 acc = (f32x4){0.f, 0.f, 0.f, 0.f};
#pragma unroll
        for (int ks = 0; ks < 2; ++ks) { const bf16x8 kf = *(const LAS bf16x8*)(KDT + (16 * dt + r) * 72 + 32 * ks + 8 * q); acc = __builtin_amdgcn_mfma_f32_16x16x32_bf16(kf, vf[ks], acc, 0, 0, 0); }
        { u32x2 wv; wv.x = cvt_pk_bf16(acc[0], acc[1]); wv.y = cvt_pk_bf16(acc[2], acc[3]); *(u32x2*)(cs + (16 * w + r) * 128 + 16 * dt + 4 * q) = wv; }
    }
    __syncthreads();
}

__device__ __forceinline__ void sample_item(int its, int l, ArgsP a, const bf16_t* ZB, const float* GB, bf16_t* MIX, LAS unsigned char* lds, int tid) {
    const int b = its >> 2, h = its & 3; const size_t row0 = (size_t)MP + 4 * b;
    const int lane = tid & 63, wave = tid >> 6;
    LAS float* QKF = (LAS float*)lds;
    LAS float* VG = (LAS float*)(lds + 6144);
    LAS float* OP = (LAS float*)(lds + 10240);
    LAS float* RS = (LAS float*)(lds + 18432);
    {
        const int t = tid >> 7, d = tid & 127; const bf16_t* zr = ZB + (row0 + t) * INC + h * 128 + d;
        QKF[(0 * 4 + t) * 128 + d] = bf2f(zr[0]); QKF[(1 * 4 + t) * 128 + d] = bf2f(zr[512]);
        QKF[(2 * 4 + t) * 128 + d] = __expf(GB[(row0 + t) * 512 + h * 128 + d]);
        VG[(0 * 4 + t) * 128 + d] = bf2f(zr[1024]); VG[(1 * 4 + t) * 128 + d] = bf2f(zr[1536]);
    }
    const int v = tid & 127, dq = tid >> 7;
    float S[32];
    const size_t sbase = (((size_t)l * DBATCH + b) * NH + h) * 16384 + (size_t)(32 * dq) * 128 + v;
    const float* sp = a->in[I_SHG] + sbase;
#pragma unroll
    for (int i = 0; i < 32; ++i) S[i] = sp[i * 128];
    __syncthreads();
#pragma unroll
    for (int t = 0; t < 4; ++t) {
        const float vt = VG[(0 * 4 + t) * 128 + v]; float acc = 0.f;
        const float fq_ = QKF[(2 * 4 + t) * 128 + 32 * dq + (lane & 31)], kq_ = QKF[(1 * 4 + t) * 128 + 32 * dq + (lane & 31)], qq_ = QKF[(0 * 4 + t) * 128 + 32 * dq + (lane & 31)];
#pragma unroll
        for (int i = 0; i < 32; ++i) {
            const float fi = __builtin_bit_cast(float, __builtin_amdgcn_readlane(__builtin_bit_cast(int, fq_), i));
            const float ki = __builtin_bit_cast(float, __builtin_amdgcn_readlane(__builtin_bit_cast(int, kq_), i));
            const float qi = __builtin_bit_cast(float, __builtin_amdgcn_readlane(__builtin_bit_cast(int, qq_), i));
            S[i] = fi * S[i] + ki * vt; acc += qi * S[i]; }
        OP[(dq * 4 + t) * 128 + v] = acc;
    }
    float* so = a->out + O_HGS + sbase;
#pragma unroll
    for (int i = 0; i < 32; ++i) so[i * 128] = S[i];
    __syncthreads();
    {
        const int t = tid >> 7;
        const float ov = OP[(0 * 4 + t) * 128 + v] + OP[(1 * 4 + t) * 128 + v] + OP[(2 * 4 + t) * 128 + v] + OP[(3 * 4 + t) * 128 + v];
        const float sq = wave_sum(ov * ov);
        if (lane == 0) RS[wave] = sq;
        __syncthreads();
        const float tot = RS[wave & ~1] + RS[wave | 1];
        const float rn = rsqrtf(tot * (1.f / 128.f) + EPS);
        const float o = ov * rn * a->in[I_HGN][l * 512 + h * 128 + v] * VG[(1 * 4 + t) * 128 + v];
        MIX[(row0 + t) * D + h * 128 + v] = (DBG_MASK & 4) ? (bf16_t)0 : (bf16_t)f2bf(o);
    }
    __syncthreads();
}

__device__ __forceinline__ void pool_item(int ip, int l, ArgsP a, const bf16_t* ZB, const bf16_t* PWT, bf16_t* MIX, LAS unsigned char* lds, int tid) {
    const int cc = tid & 127, p = tid >> 7, lane = tid & 63, w8 = tid >> 6, r = lane & 15, q = lane >> 4;
    LAS bf16_t* DA = (LAS bf16_t*)lds;
    float dd[2][16]; int g0, L; size_t rowbase;
    const char* zbb = (const char*)ZB; const char* spb = (const char*)a->in[I_SPOOL]; char* outb = (char*)a->out;
    if (ip < NB * NCH * 2) {
        const int b = ip / (NCH * 2), rem = ip - b * (NCH * 2), c = rem >> 1; g0 = (rem & 1) * 2;
        const int t0 = c == 0 ? 0 : NMETA + 64 * (c - 1); L = c == 0 ? NMETA : 64; rowbase = (size_t)b * TP + t0;
        const bool pv = 16 * p < L;
        float uu[2][31];
#pragma unroll
        for (int gi = 0; gi < 2; ++gi)
#pragma unroll
            for (int j = 0; j < 31; ++j) { const int t = t0 + 16 * p - 15 + j; const int tc = (pv && t >= 0) ? t : 0;
                const unsigned boff = (unsigned)(((b * TP + tc) * INC + 2048 + (g0 + gi) * 128 + cc) * 2);
                uu[gi][j] = bf2f(*(const unsigned short*)(zbb + boff)); }
#pragma unroll
        for (int gi = 0; gi < 2; ++gi) {
            const int g = g0 + gi, w = 2 << g;
#pragma unroll
            for (int j = 0; j < 31; ++j) { const int t = t0 + 16 * p - 15 + j; uu[gi][j] = (pv && t >= 0) ? uu[gi][j] : 0.f; }
#pragma unroll
            for (int i = 0; i < 16; ++i) {
                const int t = t0 + 16 * p + i; float s = 0.f;
#pragma unroll
                for (int j = 0; j < 16; ++j) if (j < w) s += uu[gi][15 + i - j];
                const float cnt = (float)min(w, t + 1);
                dd[gi][i] = pv ? (s / cnt - uu[gi][15 + i]) : 0.f;
                if (c == NCH - 1) { const int jj = t - (TP - PST); if (jj >= 0) *(float*)(outb + (unsigned)((O_POOLP + ((l * NB + b) * PST + jj) * 512 + g * 128 + cc) * 4)) = uu[gi][15 + i]; }
            }
        }
    } else {
        const int is = ip - NB * NCH * 2; const int sb = is >> 1; g0 = (is & 1) * 2; L = 64; rowbase = (size_t)MP + 64 * sb;
#pragma unroll
        for (int gi = 0; gi < 2; ++gi) {
            const int g = g0 + gi, w = 2 << g; const float invw = 1.f / (float)w;
#pragma unroll
            for (int bi = 0; bi < 4; ++bi) {
                const int bb = 16 * sb + 4 * p + bi; float ext[19];
#pragma unroll
                for (int j = 0; j < 15; ++j) ext[j] = *(const float*)(spb + (unsigned)((((l * DBATCH + bb) * PST + j) * 512 + g * 128 + cc) * 4));
#pragma unroll
                for (int t = 0; t < 4; ++t) ext[15 + t] = bf2f(*(const unsigned short*)(zbb + (unsigned)(((MP + 4 * bb + t) * INC + 2048 + g * 128 + cc) * 2)));
#pragma unroll
                for (int t = 0; t < 4; ++t) { float s = 0.f;
#pragma unroll
                    for (int j = 0; j < 16; ++j) if (j < w) s += ext[15 + t - j];
                    dd[gi][4 * bi + t] = s * invw - ext[15 + t]; }
#pragma unroll
                for (int j = 0; j < 15; ++j) *(float*)(outb + (unsigned)((O_POOLS + ((l * DBATCH + bb) * PST + j) * 512 + g * 128 + cc) * 4)) = ext[4 + j];
            }
        }
    }
#pragma unroll
    for (int gi = 0; gi < 2; ++gi)
#pragma unroll
        for (int i = 0; i < 16; ++i) DA[(gi * 64 + 16 * p + i) * 136 + cc] = (bf16_t)f2bf(dd[gi][i]);
    __syncthreads();
#pragma unroll
    for (int gi = 0; gi < 2; ++gi) {
        const int g = g0 + gi;
        bf16x8 bfr[4];
#pragma unroll
        for (int ks = 0; ks < 4; ++ks) bfr[ks] = *(const bf16x8*)(PWT + (size_t)g * 16384 + (16 * w8 + r) * 128 + 32 * ks + 8 * q);
#pragma unroll
        for (int tt = 0; tt < 4; ++tt) {
            f32x4 acc = (f32x4){0.f, 0.f, 0.f, 0.f};
#pragma unroll
            for (int ks = 0; ks < 4; ++ks) { const bf16x8 af = *(const LAS bf16x8*)(DA + (gi * 64 + 16 * tt + r) * 136 + 32 * ks + 8 * q); acc = __builtin_amdgcn_mfma_f32_16x16x32_bf16(bfr[ks], af, acc, 0, 0, 0); }
            if (16 * tt + r < L) { u32x2 wv; wv.x = cvt_pk_bf16(acc[0], acc[1]); wv.y = cvt_pk_bf16(acc[2], acc[3]);
                *(u32x2*)(MIX + (rowbase + 16 * tt + r) * D + 512 + g * 128 + 16 * w8 + 4 * q) = wv; }
        }
    }
    __syncthreads();
}

__device__ __forceinline__ void hgrn_scan(int l, ArgsP a, const bf16_t* CS, bf16_t* SB, const float* DEC, int gt, int ngt) {
    for (int idx = gt; idx < NB * NH * 128 * 32; idx += ngt) {
        const int d4 = idx & 31, v = (idx >> 5) & 127, bh = idx >> 12;
        f32x4 S = (f32x4){0.f, 0.f, 0.f, 0.f};
        const bf16_t* cs = CS + (size_t)bh * NCH * 16384 + v * 128 + 4 * d4; const float* dc = DEC + (size_t)bh * NCH * 128 + 4 * d4;
        bf16_t* sb = SB + (size_t)bh * NCH * 16384 + v * 128 + 4 * d4;
#pragma unroll 1
        for (int c0 = 0; c0 < NCH; c0 += 11) {
            f32x4 loc[11], de[11];
#pragma unroll
            for (int j = 0; j < 11; ++j) { const u32x2 w = *(const u32x2*)(cs + (size_t)(c0 + j) * 16384); de[j] = *(const f32x4*)(dc + (c0 + j) * 128);
                loc[j] = (f32x4){__builtin_bit_cast(float, w.x << 16), __builtin_bit_cast(float, w.x & 0xffff0000u), __builtin_bit_cast(float, w.y << 16), __builtin_bit_cast(float, w.y & 0xffff0000u)}; }
#pragma unroll
            for (int j = 0; j < 11; ++j) {
                u32x2 w; w.x = cvt_pk_bf16(S[0], S[1]); w.y = cvt_pk_bf16(S[2], S[3]);
                *(u32x2*)(sb + (size_t)(c0 + j) * 16384) = w;
                S = de[j] * S + loc[j];
            }
        }
        float* o = a->out + O_HGP + ((size_t)l * NB * NH + bh) * 16384 + (size_t)(4 * d4) * 128 + v;
        o[0] = S[0]; o[128] = S[1]; o[256] = S[2]; o[384] = S[3];
    }
}

__device__ __forceinline__ void hgrn_out_item(int it, int l, ArgsP a, const bf16_t* ZB, const float* GB, const bf16_t* SB, bf16_t* MIX, LAS unsigned char* lds, int tid) {
    const ChunkGeo G = chunk_geo(it);
    const int d = tid & 127, p = tid >> 7, lane = tid & 63, w = tid >> 6, r = lane & 15, q = lane >> 4;
    LAS float* TOT = (LAS float*)lds;
    LAS float* RR = (LAS float*)(lds + 2048);
    LAS float* RS = (LAS float*)(lds + 4096);
    LAS bf16_t* QS = (LAS bf16_t*)(lds + 6144);
    LAS bf16_t* QE = (LAS bf16_t*)(lds + 23552);
    LAS bf16_t* VS = (LAS bf16_t*)(lds + 40960);
    LAS bf16_t* PP = (LAS bf16_t*)(lds + 58368);
    LAS bf16_t* KS = (LAS bf16_t*)(lds + 67584);
    const bool pv = (16 * p < G.L);
    float bb[16]; unsigned short qraw[16], kraw[16]; u32x4 vv[2]; bf16x8 sf[4]; u32x2 graw[4];
    const int prow = pv ? 16 * p : 0;
#pragma unroll
    for (int i = 0; i < 16; ++i) bb[i] = GB[(G.r0 + prow + i) * 512 + G.h * 128 + d];
#pragma unroll
    for (int i = 0; i < 16; ++i) { qraw[i] = ZB[(G.r0 + prow + i) * INC + G.h * 128 + d]; kraw[i] = ZB[(G.r0 + prow + i) * INC + 512 + G.h * 128 + d]; }
#pragma unroll
    for (int e2 = 0; e2 < 2; ++e2) { const int e = tid + 512 * e2, s = e >> 4, ch = e & 15; const int sc = s < G.L ? s : 0;
        vv[e2] = *(const u32x4*)(ZB + (G.r0 + sc) * INC + 1024 + G.h * 128 + ch * 8); }
    {
        const bf16_t* st = SB + (size_t)it * 16384 + (16 * w + r) * 128 + 8 * q;
#pragma unroll
        for (int ks = 0; ks < 4; ++ks) sf[ks] = *(const bf16x8*)(st + 32 * ks);
    }
#pragma unroll
    for (int tt = 0; tt < 4; ++tt) { const int tc = (16 * tt + r < G.L) ? 16 * tt + r : 0; graw[tt] = *(const u32x2*)(ZB + (G.r0 + tc) * INC + 1536 + G.h * 128 + 16 * w + 4 * q); }
#pragma unroll
    for (int i = 0; i < 16; ++i) { bb[i] = pv ? bb[i] : 0.f; qraw[i] = pv ? qraw[i] : (unsigned short)0; kraw[i] = pv ? kraw[i] : (unsigned short)0; }
#pragma unroll
    for (int e2 = 0; e2 < 2; ++e2) { const int e = tid + 512 * e2, s = e >> 4; if (s >= G.L) vv[e2] = (u32x4){0u, 0u, 0u, 0u}; }
    float run = 0.f;
#pragma unroll
    for (int i = 0; i < 16; ++i) { run += bb[i]; bb[i] = run; }
    TOT[p * 128 + d] = run;
#pragma unroll
    for (int e2 = 0; e2 < 2; ++e2) { const int e = tid + 512 * e2, s = e >> 4, ch = e & 15; *(LAS u32x4*)(VS + s * 136 + ch * 8) = vv[e2]; }
    __syncthreads();
    float off = 0.f;
#pragma unroll
    for (int pp = 0; pp < 4; ++pp) { const float tv = TOT[pp * 128 + d]; if (pp < p) off += tv; }
#pragma unroll
    for (int i = 0; i < 16; ++i) bb[i] += off;
    RR[p * 128 + d] = bb[0];
#pragma unroll
    for (int i = 0; i < 16; ++i) {
        const float qv = bf2f(qraw[i]);
        QS[(16 * p + i) * 136 + d] = (bf16_t)f2bf(qv * __expf(bb[i] - bb[0]));
        QE[(16 * p + i) * 136 + d] = (bf16_t)f2bf(qv * __expf(bb[i]));
    }
    float kv[16];
#pragma unroll
    for (int i = 0; i < 16; ++i) kv[i] = bf2f(kraw[i]);
    __syncthreads();
#pragma unroll
    for (int I = 0; I < 4; ++I) {
        if (I >= p) {
            const float ref = RR[I * 128 + d]; const int base = 8 * I * (I + 1);
#pragma unroll
            for (int i = 0; i < 16; ++i) KS[(base + 16 * p + i) * 136 + d] = (bf16_t)f2bf(kv[i] * __expf(ref - bb[i]));
        }
    }
    __syncthreads();
#pragma unroll
    for (int h2 = 0; h2 < 2; ++h2) {
        const int id = w + 8 * h2, I = id >> 2, J = id & 3;
        f32x4 acc = (f32x4){0.f, 0.f, 0.f, 0.f};
        if (J <= I) {
#pragma unroll
            for (int ks = 0; ks < 4; ++ks) {
                const bf16x8 af = *(const LAS bf16x8*)(QS + (16 * I + r) * 136 + 32 * ks + 8 * q);
                const bf16x8 bf = *(const LAS bf16x8*)(KS + (8 * I * (I + 1) + 16 * J + r) * 136 + 32 * ks + 8 * q);
                acc = __builtin_amdgcn_mfma_f32_16x16x32_bf16(af, bf, acc, 0, 0, 0);
            }
        }
#pragma unroll
        for (int j = 0; j < 4; ++j) {
            float sv = acc[j]; if (J > I || (J == I && r > 4 * q + j)) sv = 0.f;
            PP[(16 * I + 4 * q + j) * 72 + 16 * J + r] = (bf16_t)f2bf(sv);
        }
    }
    __syncthreads();
    bf16x8 vf[2];
#pragma unroll
    for (int ks = 0; ks < 2; ++ks) vf[ks] = tr_frag(VS, 136, 32 * ks, 16 * w, r, q);
    f32x4 acc[4];
#pragma unroll
    for (int tt = 0; tt < 4; ++tt) {
        acc[tt] = (f32x4){0.f, 0.f, 0.f, 0.f};
#pragma unroll
        for (int ks = 0; ks < 2; ++ks) { const bf16x8 pf = *(const LAS bf16x8*)(PP + (16 * tt + r) * 72 + 32 * ks + 8 * q); acc[tt] = __builtin_amdgcn_mfma_f32_16x16x32_bf16(vf[ks], pf, acc[tt], 0, 0, 0); }
#pragma unroll
        for (int ks = 0; ks < 4; ++ks) { const bf16x8 qf = *(const LAS bf16x8*)(QE + (16 * tt + r) * 136 + 32 * ks + 8 * q); acc[tt] = __builtin_amdgcn_mfma_f32_16x16x32_bf16(sf[ks], qf, acc[tt], 0, 0, 0); }
        float s = (acc[tt][0] * acc[tt][0] + acc[tt][1] * acc[tt][1]) + (acc[tt][2] * acc[tt][2] + acc[tt][3] * acc[tt][3]);
        s += __shfl_xor(s, 16); s += __shfl_xor(s, 32);
        if (q == 0) RS[w * 64 + 16 * tt + r] = s;
    }
    __syncthreads();
    const f32x4 hgn = *(const f32x4*)(a->in[I_HGN] + l * 512 + G.h * 128 + 16 * w + 4 * q);
#pragma unroll
    for (int tt = 0; tt < 4; ++tt) {
        const int t = 16 * tt + r;
        float tot = 0.f;
#pragma unroll
        for (int ww = 0; ww < 8; ++ww) tot += RS[ww * 64 + t];
        const float rn = rsqrtf(tot * (1.f / 128.f) + EPS);
        if (t < G.L) {
            const size_t row = G.r0 + t;
            const u32x2 gt2 = graw[tt];
            const float g0 = bf2f((unsigned short)(gt2.x & 0xffffu)), g1 = bf2f((unsigned short)(gt2.x >> 16)), g2 = bf2f((unsigned short)(gt2.y & 0xffffu)), g3 = bf2f((unsigned short)(gt2.y >> 16));
            u32x2 wv; wv.x = cvt_pk_bf16(acc[tt][0] * rn * hgn[0] * g0, acc[tt][1] * rn * hgn[1] * g1); wv.y = cvt_pk_bf16(acc[tt][2] * rn * hgn[2] * g2, acc[tt][3] * rn * hgn[3] * g3);
            if (DBG_MASK & 1) wv = (u32x2){0u, 0u};
            *(u32x2*)(MIX + row * D + G.h * 128 + 16 * w + 4 * q) = wv;
        }
    }
    __syncthreads();
}

__device__ __forceinline__ void final_rows(ArgsP a, const bf16_t* XB, int m0, int m_end, int step, int lane) {
    const float* nf = a->in[I_NF]; float* outp = a->out;
    for (int m = m0; m < m_end; m += step) {
        float* o;
        if (m < MP) { const int b = m / TP, t = m - b * TP; if (t < NMETA) continue; o = outp + O_YP + ((size_t)b * SEQ + (t - NMETA)) * D; }
        else o = outp + O_YS + (size_t)(m - MP) * D;
        f32x4 x[4]; float s = 0.f;
#pragma unroll
        for (int j = 0; j < 4; ++j) { const u32x2 w = ((const u32x2*)(XB + (size_t)m * D))[lane + 64 * j];
            x[j] = (f32x4){__builtin_bit_cast(float, w.x << 16), __builtin_bit_cast(float, w.x & 0xffff0000u), __builtin_bit_cast(float, w.y << 16), __builtin_bit_cast(float, w.y & 0xffff0000u)};
            s += (x[j][0] * x[j][0] + x[j][1] * x[j][1]) + (x[j][2] * x[j][2] + x[j][3] * x[j][3]); }
        const float rstd = rsqrtf(wave_sum(s) * (1.f / D) + EPS);
#pragma unroll
        for (int j = 0; j < 4; ++j) { const f32x4 gn = ((const f32x4*)nf)[lane + 64 * j]; ((f32x4*)o)[lane + 64 * j] = x[j] * rstd * gn; }
    }
}

__global__ void __launch_bounds__(512, 2) mk_fwd(Args a_) {
    __shared__ __attribute__((aligned(16))) unsigned char lds_raw[LDS_BYTES];
    LAS unsigned char* lds = (LAS unsigned char*)lds_raw;
    const int ph_lo = a_.ph_lo, ph_hi = a_.ph_hi;
    volatile LAS unsigned* bst = (volatile LAS unsigned*)(lds + LDS_BYTES - 64);
    XcdBarrier bar; bar.bar = (unsigned*)(a_.ws + WS_CTL); bar.x = 0; bar.st = bst;
    if (ph_hi - ph_lo > 1) {
        if (threadIdx.x < 16) bst[threadIdx.x] = 0u;
        __syncthreads();
        bar = xcd_barrier_post((unsigned*)(a_.ws + WS_CTL), bst);
    }

    for (int ph = ph_lo; ph < ph_hi; ++ph) {
        ArgsP a = (ArgsP)__builtin_amdgcn_kernarg_segment_ptr();
        asm volatile("" : "+s"(a));
        int tid = threadIdx.x; asm volatile("" : "+v"(tid));
        const int lane = tid & 63, wave = __builtin_amdgcn_readfirstlane(tid >> 6);
        const int G = gridDim.x, bx = blockIdx.x;
        const int gw = bx * 8 + wave, NGW = G * 8;
        unsigned char* ws = a->ws;
        float* SS = (float*)(ws + WS_SS);
        float* LB = (float*)(ws + WS_LB);
        float* DEC = (float*)(ws + WS_DEC);
        float* X = (float*)(ws + WS_X);
        bf16_t* XB = (bf16_t*)(ws + WS_XB);
        bf16_t* MIX = (bf16_t*)(ws + WS_MIX);
        bf16_t* HB = (bf16_t*)(ws + WS_HZ);
        bf16_t* ZB = (bf16_t*)(ws + WS_HZ);
        float* GB = (float*)(ws + WS_HZ + (size_t)MPAD * INC * 2);
        bf16_t* CS = (bf16_t*)(ws + WS_CS);
        LAS float* scr = (LAS float*)(lds + wave * 8448);
        if (ph == 0) {
            for (int m = gw; m < MPAD; m += NGW) {
                const float* src = a->in[I_META];
                if (m < MP) { const int b = m / TP, t = m - b * TP; src = t < NMETA ? a->in[I_META] + (size_t)t * D : a->in[I_XP] + ((size_t)b * SEQ + (t - NMETA)) * D; }
                else if (m < MT) src = a->in[I_XS] + (size_t)(m - MP) * D;
                f32x4 v[4]; float s = 0.f;
#pragma unroll
                for (int j = 0; j < 4; ++j) v[j] = ((const f32x4*)src)[lane + 64 * j];
#pragma unroll
                for (int j = 0; j < 4; ++j) { if (m >= MT) v[j] = (f32x4){0.f, 0.f, 0.f, 0.f}; s += (v[j][0] * v[j][0] + v[j][1] * v[j][1]) + (v[j][2] * v[j][2] + v[j][3] * v[j][3]); }
                s = wave_sum(s);
#pragma unroll
                for (int j = 0; j < 4; ++j) {
                    u32x2 wv; wv.x = cvt_pk_bf16(v[j][0], v[j][1]); wv.y = cvt_pk_bf16(v[j][2], v[j][3]);
                    ((u32x2*)(XB + (size_t)m * D))[lane + 64 * j] = wv;
                    if (m >= MT) ((u32x2*)(MIX + (size_t)m * D))[lane + 64 * j] = (u32x2){0u, 0u};
                }
                if (lane < 16) SS[(size_t)m * 16 + lane] = lane == 0 ? s : 0.f;
            }
            {
                const int c = bx * 512 + tid;
                if (c < 512) {
                    float lg[4], mx = -1e30f;
#pragma unroll
                    for (int i = 0; i < 4; ++i) { lg[i] = a->in[I_LBL][i * 512 + c]; mx = fmaxf(mx, lg[i]); }
                    float sum = 0.f;
#pragma unroll
                    for (int i = 0; i < 4; ++i) { lg[i] = expf(lg[i] - mx); sum += lg[i]; }
                    const float inv = 1.f / sum; float cum = 0.f;
                    LB[c] = 0.f;
#pragma unroll
                    for (int i = 1; i < 4; ++i) { cum += lg[i] * inv; LB[i * 512 + c] = cum; }
                }
            }
            wconv_layer(a, 0, (bf16_t*)(ws + WS_W), scr, gw, NGW, lane);
            __syncthreads();
        } else if (ph == NPH - 1) {
            final_rows(a, XB, MMAIN + gw, MT, NGW, lane);
        } else {
            const int l = (ph - 1) / NK, k = KSEQ[(ph - 1) % NK];
            bf16_t* wset = (bf16_t*)(ws + WS_W + (size_t)(l & 1) * WSET_BYTES);
            bf16_t* wprev = (bf16_t*)(ws + WS_W + (size_t)((l + 1) & 1) * WSET_BYTES);
            bf16_t* HSv = (bf16_t*)(ws + WS_HS) - (size_t)MMAIN * FF;
            unsigned* cnts = (unsigned*)(ws + WS_CTL) + 4096;
            if (k == 3) {
                constexpr int NPI = NB * NCH * 2 + 16;
                constexpr int NIT = NHI + 512 + NPI; const int nrounds = (NIT + G - 1) / G;
                static_assert(NIT == 2112, "item list layout below");
                for (int k2 = 0; k2 < nrounds; ++k2) {
                    const int it = bx + ((k2 + bx) % nrounds) * G; if (it >= NIT) continue;
                    int t2 = tid; asm volatile("" : "+v"(t2));
                    if (it < 1024) hgrn_local_item(chunk_slot(it), ZB, GB, CS, DEC, lds, t2);
                    else if (it < 1536) sample_item(it - 1024, l, a, ZB, GB, MIX, lds, t2);
                    else if (it < 2048) { const int j = it - 1536, b_ = j >> 6, rem = j & 63; pool_item(b_ * (NCH * 2) + (1 + (rem >> 1)) * 2 + (rem & 1), l, a, ZB, wset + WO_PW, MIX, lds, t2); }
                    else if (it < 2080) hgrn_local_item(chunk_slot(1024 + (it - 2048)), ZB, GB, CS, DEC, lds, t2);
                    else if (it < 2096) { const int j = it - 2080; pool_item((j >> 1) * (NCH * 2) + (j & 1), l, a, ZB, wset + WO_PW, MIX, lds, t2); }
                    else pool_item(NB * NCH * 2 + (it - 2096), l, a, ZB, wset + WO_PW, MIX, lds, t2);
                }
            } else if (k == 4) {
                hgrn_scan(l, a, CS, (bf16_t*)(ws + WS_SB), DEC, bx * 512 + tid, G * 512);
                if (l + 1 < DEPTH) wconv_layer(a, l + 1, (bf16_t*)(ws + WS_W + (size_t)((l + 1) & 1) * WSET_BYTES), scr, gw, NGW, lane);
                __syncthreads();
            } else if (k == 5) {
                for (int it = bx; it < NHI; it += G) hgrn_out_item(chunk_slot(it), l, a, ZB, GB, (const bf16_t*)(ws + WS_SB), MIX, lds, tid);
            } else {
                const bool lastph = (ph == NPH - 2);
                const bool split = (k == 2) || lastph;
                const int nded = split ? 24 : NDED;
                {
                    const bool full = (k == 1 || k == 6 || k == 8);
                    const bool prod = !full && bx < (split ? 24 : NPROD) && !(k == 0 && l == 0);
                    if (full || prod) {
                        const int kk = full ? k : (k == 2 ? 1 : (k == 7 ? 6 : 8));
                        const bf16_t* wr_set = (k == 0) ? wprev : wset;
                        const int Kk = kk == 6 ? D : FF;
                        pg8::Gemm g = pg8::mk_gemm(full ? (kk == 6 ? MIX : HB) : (kk == 6 ? MIX : HSv), wr_set + (kk == 1 ? WO_1O : (kk == 8 ? WO_2O : WO_OUT)), MPAD, D, Kk);
                        pg8::Order S; int mode = 0; unsigned* pc = cnts + 64 * (12 + l * 12 + (bx >> 1));
                        if (full) S.init_static(MMAIN, D, G, bx);
                        else if (split) { S.init_list(4, bx >> 1, 0, 1); g.nt = Kk / 128; g.koff = (bx & 1) * (Kk / 2) * 2; mode = 1 + (bx & 1); }
                        else S.init_list(4, bx, 0, 1);
                        pg8::EpiResid E{X, XB, SS, kk == 6 ? 1.0f : 0.5f, mode, pc};
                        pg8::gemm_phase<pg8::EpiResid, pg8::Order, true, true>(lds, g, S, E, tid);
                        if (prod) handoff_publish(mode == 1 ? pc : cnts + 64 * ((k == 0 ? (l - 1) * 3 + 2 : l * 3 + (k == 2 ? 0 : 1))));
                    }
                }
                if (lastph) {
                    if (bx >= nded) final_rows(a, XB, (bx - nded) * 8 + wave, MMAIN, (G - nded) * 8, lane);
                } else if (k == 0 || k == 7) {
#pragma unroll 1
                    for (int pass = 0; pass < 2; ++pass) {
                        pg8::Gemm g = pg8::mk_gemm(XB, wset + (k == 0 ? WO_1I : WO_2I), MPAD, FF2, D); pg8::Order S; pg8::EpiSwiGLU E{pass ? HSv : HB, SS};
                        if (pass == 0) { if (bx < NDED) continue; S.init_static(MMAIN, FF2, G - NDED, bx - NDED); }
                        else {
                            if (k == 0 && l == 0) { if (bx < NDED) S.init_list(22, bx, NDED, bx < 2 ? 5 : 4); else break; }
                            else if (k == 0) { if (bx < NPROD) S.init_list(22, bx, NPROD, 3); else if (bx < NDED) S.init_list(22, 36 + (bx - NPROD), 4, 3); else if (bx >= G - 18) S.init_list(22, 48 + (bx - (G - 18)), 0, 1); else break; }
                            else { if (bx < NPROD) S.init_list(22, bx, NPROD, 4); else if (bx < NDED) S.init_list(22, 48 + (bx - NPROD), 4, bx - NPROD < 2 ? 5 : 4); else break; }
                            if (!(k == 0 && l == 0)) handoff_wait(cnts + 64 * (k == 0 ? (l - 1) * 3 + 2 : l * 3 + 1), NPROD);
                        }
                        pg8::gemm_phase<pg8::EpiSwiGLU, pg8::Order, true, true>(lds, g, S, E, tid);
                    }
                } else if (k == 2) {
#pragma unroll 1
                    for (int pass = 0; pass < 2; ++pass) {
                        pg8::Gemm g = pg8::mk_gemm(XB, wset + WO_IN, MPAD, INC, D); pg8::Order S; pg8::EpiMix E{ZB, GB, SS, LB + l * 512};
                        if (pass == 0) { if (bx < nded) continue; S.init_static(MMAIN, INC, G - nded, bx - nded); }
                        else {
                            if (bx < nded) S.init_list(10, bx, 0, 1); else if (bx >= G - 6) S.init_list(10, 24 + (bx - (G - 6)), 0, 1); else break;
                            handoff_wait(cnts + 64 * (l * 3 + 0), NPROD);
                        }
                        pg8::gemm_phase<pg8::EpiMix, pg8::Order, true, true>(lds, g, S, E, tid);
                    }
                }
            }
        }
        if (ph + 1 < ph_hi) {
            if (ph == ph_lo) cg::this_grid().sync();
            else xcd_barrier(bar);
        }
    }
}

extern "C" void kernel_launch(void* const* d_in, const int* in_sizes, int n_in, void* d_out, int out_size, void* d_ws, size_t ws_size, hipStream_t stream) {
    static int grid = 0;
    if (grid == 0) {
        if (n_in != 19 || ws_size < WS_END) { fprintf(stderr, "kernel_launch: unexpected inputs (n_in %d, ws %zu < %zu)\n", n_in, ws_size, (size_t)WS_END); grid = -1; return; }
        int dev = 0, cus = 0, per_cu = 0;
        (void)hipGetDevice(&dev);
        (void)hipDeviceGetAttribute(&cus, hipDeviceAttributeMultiprocessorCount, dev);
        (void)hipOccupancyMaxActiveBlocksPerMultiprocessor(&per_cu, (const void*)mk_fwd, 512, 0);
        if (per_cu < 1) per_cu = 1;
        (void)hipGetLastError();
        grid = cus * 1;
    }
    if (grid < 0) return;
    (void)hipMemsetAsync((char*)d_ws, 0, ZERO_BYTES, stream);
    Args a{};
    for (int i = 0; i < 19; ++i) a.in[i] = (const float*)d_in[i];
    a.out = (float*)d_out; a.ws = (unsigned char*)d_ws;
#if ONE_LAUNCH
    a.ph_lo = 0; a.ph_hi = NPH;
    void* args[] = {&a};
    hipError_t e = hipLaunchCooperativeKernel((const void*)mk_fwd, dim3(grid), dim3(512), args, 0, stream);
    if (e != hipSuccess) fprintf(stderr, "cooperative launch failed: %s (grid %d)\n", hipGetErrorString(e), grid);
#else
    for (int ph = 0; ph < NPH; ++ph) {
        if (ph >= DBG_NPH && ph != NPH - 1) continue;
        a.ph_lo = ph; a.ph_hi = ph + 1;
        hipLaunchKernelGGL(mk_fwd, dim3(grid), dim3(512), 0, stream, a);
    }
#endif
}
```

```cpp
#include <hip/hip_runtime.h>
#include <hip/hip_cooperative_groups.h>
#include <cstdio>
#include <cstdint>
namespace cg = cooperative_groups;

#ifndef ONE_LAUNCH
#define ONE_LAUNCH 1
#endif
#ifndef DBG_MASK
#define DBG_MASK 0
#endif
#ifndef DBG_NPH
#define DBG_NPH 37
#endif

#define LAS __attribute__((address_space(3)))
typedef unsigned short bf16_t;
typedef short bf16x8 __attribute__((ext_vector_type(8)));
typedef float f32x4 __attribute__((ext_vector_type(4)));
typedef unsigned u32x4 __attribute__((ext_vector_type(4)));
typedef unsigned u32x2 __attribute__((ext_vector_type(2)));

constexpr int D = 1024, NB = 8, SEQ = 2048, NMETA = 16, TP = SEQ + NMETA, DEPTH = 4, DBATCH = 128, DSEQ = 4;
constexpr int MP = NB * TP;
constexpr int MS = DBATCH * DSEQ;
constexpr int MT = MP + MS;
constexpr int MPAD = 17152;
constexpr int NH = 4, FF = 2816, FF2 = 5632, INC = 2560, PST = 15;
constexpr int NCH = 33;
constexpr int NHI = NB * NH * NCH;
constexpr float EPS = 1e-6f;

constexpr size_t O_YP = 0, O_YS = 16777216, O_HGP = 17301504, O_POOLP = 19398656, O_HGS = 19644416, O_POOLS = 53198848;

constexpr size_t WS_CTL = 0;
constexpr size_t WS_SS = 65536;
constexpr size_t SS_BYTES = (size_t)16 * MPAD * 4;
constexpr size_t ZERO_BYTES = 65536;
constexpr size_t WS_LB = 0x120000;
constexpr size_t WS_DEC = WS_LB + 65536;
constexpr size_t WS_W = 2u << 20;
constexpr size_t WSET_BYTES = 42074112;
constexpr size_t WS_X = WS_W + 2 * WSET_BYTES + 0;
constexpr size_t WS_XB = WS_X + (size_t)MPAD * D * 4;
constexpr size_t WS_MIX = WS_XB + (size_t)MPAD * D * 2;
constexpr size_t WS_HZ = WS_MIX + (size_t)MPAD * D * 2;
constexpr size_t HZ_BYTES = (size_t)MPAD * INC * 2 + (size_t)MPAD * 512 * 4;
constexpr size_t WS_CS = WS_HZ + HZ_BYTES;
constexpr size_t WS_SB = WS_CS + (size_t)NHI * 16384 * 4;
constexpr size_t WS_HS = WS_SB + (size_t)NHI * 16384 * 2;
constexpr size_t WS_END = WS_HS + (size_t)768 * FF * 2;
constexpr int MMAIN = 16384, NDED = 16, NPROD = 12;
constexpr size_t WO_1I = 0, WO_1O = 5767168, WO_IN = 8650752, WO_OUT = 11272192, WO_2I = 12320768, WO_2O = 18087936, WO_PW = 20971520;

constexpr int LDS_BYTES = 135168;
#ifndef DBG_REPM
#define DBG_REPM 0
#endif
#if DBG_REPM
constexpr int NK = 12;
__device__ const int KSEQ[NK] = {0, 1, 2, 3, 3, 4, 4, 5, 5, 6, 7, 8};
#else
constexpr int NK = 9;
__device__ const int KSEQ[NK] = {0, 1, 2, 3, 4, 5, 6, 7, 8};
#endif
constexpr int NPH = 2 + DEPTH * NK;

__device__ __forceinline__ unsigned f2bf(float f) { unsigned u = __builtin_bit_cast(unsigned, f); return (u + 0x7fffu + ((u >> 16) & 1u)) >> 16; }
__device__ __forceinline__ float bf2f(unsigned short h) { return __builtin_bit_cast(float, (unsigned)h << 16); }
typedef float f32x2_t __attribute__((ext_vector_type(2))); typedef __bf16 bf16x2_t __attribute__((ext_vector_type(2)));
__device__ __forceinline__ unsigned cvt_pk_bf16(float lo, float hi) { f32x2_t v = {lo, hi}; bf16x2_t b = __builtin_convertvector(v, bf16x2_t); return __builtin_bit_cast(unsigned, b); }
__device__ __forceinline__ float wave_sum(float v) {
#pragma unroll
    for (int o = 1; o < 64; o <<= 1) v += __shfl_xor(v, o);
    return v;
}
__device__ __forceinline__ float row_rstd(const float* ssp, int row) {
    const f32x4* p = (const f32x4*)(ssp + (size_t)row * 16); const f32x4 a = p[0], b = p[1], c = p[2], d = p[3];
    const float s = (((a[0] + a[1]) + (a[2] + a[3])) + ((b[0] + b[1]) + (b[2] + b[3]))) + (((c[0] + c[1]) + (c[2] + c[3])) + ((d[0] + d[1]) + (d[2] + d[3])));
    return rsqrtf(s * (1.f / D) + EPS);
}
__device__ __forceinline__ float silu_f(float x) { return x * __builtin_amdgcn_rcpf(1.f + __expf(-x)); }
__device__ __forceinline__ f32x4 swiglu4(f32x4 g, f32x4 u) {
    const f32x4 gc = __builtin_elementwise_max(g, (f32x4){-40.f, -40.f, -40.f, -40.f});
    const f32x4 t = gc * (-1.4426950408889634f);
    f32x4 a; a[0] = __builtin_amdgcn_exp2f(t[0]); a[1] = __builtin_amdgcn_exp2f(t[1]); a[2] = __builtin_amdgcn_exp2f(t[2]); a[3] = __builtin_amdgcn_exp2f(t[3]);
    a = a + 1.0f;
    const float r01 = __builtin_amdgcn_rcpf(a[0] * a[1]), r23 = __builtin_amdgcn_rcpf(a[2] * a[3]);
    const f32x4 inv = (f32x4){a[1] * r01, a[0] * r01, a[3] * r23, a[2] * r23};
    return (gc * u) * inv;
}

namespace pg8 {
constexpr int BM = 256, BK = 64, HALF = 128, HTB = HALF * BK * 2, STAGE_BYTES = 8 * HTB, NXCD = 8, WGM = 8;
__host__ __device__ __forceinline__ int lds_byte(int r, int c) { const int st = (r >> 4) * 2 + (c >> 5), rr = r & 15, cc = c & 31, ob = rr * 64 + cc * 2; return st * 1024 + (ob ^ (((ob >> 9) & 1) << 5)); }
__host__ __device__ __forceinline__ void stage_rc(int b, int& R, int& C) { const int st = b / 1024, sb = b % 1024, swz = sb ^ (((sb >> 9) & 1) << 5); R = (st >> 1) * 16 + swz / 64; C = (st & 1) * 32 + (swz % 64) / 2; }
__host__ __device__ __forceinline__ int perm32(int rho) { const int n = rho >> 4, i = rho & 15; return 8 * (i >> 2) + 4 * n + (i & 3); }

struct Unit { int pm, pn; };
struct Gemm { const bf16_t* A; const bf16_t* Bt; int M, N, K, nt, koff; };
__device__ __forceinline__ Gemm mk_gemm(const bf16_t* A, const bf16_t* Bt, int M, int N, int K) { Gemm g; g.A = A; g.Bt = Bt; g.M = M; g.N = N; g.K = K; g.nt = K / 64; g.koff = 0; return g; }

struct StaticOrder {
    int nM, nN, nwg, G, c;
    __host__ __device__ void init(int M, int N, int G_, int c_) { nM = M / BM; nN = N / BM; nwg = nM * nN; G = G_; c = c_; }
    __host__ __device__ bool next(int i, Unit& u) const {
        const long L = (long)i * G + c; if (L >= nwg) return false;
        int wgid = (int)L; { const int q = nwg / NXCD, r = nwg % NXCD, xcd = wgid % NXCD, off = wgid / NXCD; wgid = (xcd < r ? xcd * (q + 1) : r * (q + 1) + (xcd - r) * q) + off; }
        const int nig = WGM * nN, gid = wgid / nig, fm = gid * WGM, gsz = (nM - fm) < WGM ? (nM - fm) : WGM;
        u.pm = fm + ((wgid % nig) % gsz); u.pn = (wgid % nig) / gsz; return true;
    }
    __device__ __forceinline__ void a_ready(const Unit&) const {}
    __device__ __forceinline__ void done(const Unit&) const {}
};

struct Order {
    StaticOrder so; int mode, nN, first, step, n;
    __device__ void init_static(int M, int N, int G_, int c_) { mode = 0; so.init(M, N, G_, c_); nN = 0; first = 0; step = 0; n = 0; }
    __device__ void init_list(int nN_, int first_, int step_, int n_) { mode = 1; so.init(256, 256, 1, 0); nN = nN_; first = first_; step = step_; n = n_; }
    __device__ bool next(int i, Unit& u) const {
        if (mode == 0) return so.next(i, u);
        if (i >= n) return false; const int L = first + i * step; u.pm = 64 + L / nN; u.pn = L - (L / nN) * nN; return true;
    }
    __device__ __forceinline__ void a_ready(const Unit&) const {}
    __device__ __forceinline__ void done(const Unit&) const {}
};


struct EpiSwiGLU {
    static constexpr bool PERM = true, AFTER_DRAIN = false;
    bf16_t* H; const float* ss;
    __device__ __forceinline__ void operator()(const f32x4 (&acc)[2][2][4][2], const Unit& u, int wr, int wc, int fr, int fq) const {
        const int row0 = u.pm * BM + wr * 64 + fr; const int col0 = u.pn * HALF + wc * 32 + 8 * fq;
#pragma unroll
        for (int ai = 0; ai < 2; ++ai)
#pragma unroll
            for (int m = 0; m < 4; ++m) {
                const int row = row0 + ai * HALF + m * 16;
                const float rstd = row_rstd(ss, row);
                const f32x4 g0 = acc[ai][0][m][0] * rstd, g1 = acc[ai][0][m][1] * rstd, u0 = acc[ai][1][m][0] * rstd, u1 = acc[ai][1][m][1] * rstd;
                u32x4 w;
                const f32x4 h0 = swiglu4(g0, u0), h1 = swiglu4(g1, u1);
                w.x = cvt_pk_bf16(h0[0], h0[1]); w.y = cvt_pk_bf16(h0[2], h0[3]);
                w.z = cvt_pk_bf16(h1[0], h1[1]); w.w = cvt_pk_bf16(h1[2], h1[3]);
                *(u32x4*)(H + (size_t)row * FF + col0) = w;
            }
    }
};

struct EpiResid {
    static constexpr bool PERM = false, AFTER_DRAIN = false;
    float* XS; bf16_t* XB; float* ssn; float c; int mode; unsigned* pcnt;
    static __device__ __forceinline__ float store_round(bf16_t* p, const f32x4 x) {
        u32x2 w; w.x = cvt_pk_bf16(x[0], x[1]); w.y = cvt_pk_bf16(x[2], x[3]);
        *(u32x2*)p = w;
        const float r0 = __builtin_bit_cast(float, w.x << 16), r1 = __builtin_bit_cast(float, w.x & 0xffff0000u), r2 = __builtin_bit_cast(float, w.y << 16), r3 = __builtin_bit_cast(float, w.y & 0xffff0000u);
        return (r0 * r0 + r1 * r1) + (r2 * r2 + r3 * r3);
    }
    __device__ __forceinline__ void operator()(const f32x4 (&acc)[2][2][4][2], const Unit& u, int wr, int wc, int fr, int fq) const {
        const int row0 = u.pm * BM + wr * 64 + fr; const int col0 = u.pn * BM + wc * 32 + 4 * fq;
        float* xs = XS + (size_t)(u.pn + 4 * (u.pm - 64)) * 65536 + (wr * 64 + fr) * 256 + wc * 32 + 4 * fq;
        if (mode == 2) { unsigned sp = 0; while (__hip_atomic_load(pcnt, __ATOMIC_RELAXED, __HIP_MEMORY_SCOPE_AGENT) < 1u) { __builtin_amdgcn_s_sleep(2); if (++sp > (1u << 24)) break; }
            __builtin_amdgcn_fence(__ATOMIC_ACQUIRE, "agent"); asm volatile("s_waitcnt vmcnt(0)" ::: "memory"); }
        if (mode == 2) {
#pragma unroll
            for (int aim = 0; aim < 4; ++aim) { const int ai = aim >> 1, m0 = (aim & 1) * 2;
                f32x4 xv[2][2][2];
#pragma unroll
                for (int mm = 0; mm < 2; ++mm)
#pragma unroll
                    for (int bj = 0; bj < 2; ++bj)
#pragma unroll
                        for (int n = 0; n < 2; ++n) xv[mm][bj][n] = *(const f32x4*)(xs + (ai * HALF + (m0 + mm) * 16) * 256 + bj * HALF + n * 16);
#pragma unroll
                for (int mm = 0; mm < 2; ++mm) { const int m = m0 + mm; const int row = row0 + ai * HALF + m * 16; bf16_t* xb = XB + (size_t)row * D + col0; float q = 0.f;
#pragma unroll
                    for (int bj = 0; bj < 2; ++bj)
#pragma unroll
                        for (int n = 0; n < 2; ++n) { const f32x4 x = xv[mm][bj][n] + acc[ai][bj][m][n] * c; q += store_round(xb + bj * HALF + n * 16, x); }
                    q += __shfl_xor(q, 16); q += __shfl_xor(q, 32);
                    if (fq == 0) ssn[(size_t)row * 16 + u.pn * 4 + wc] = q; }
                asm volatile("" ::: "memory");
            }
        } else {
#pragma unroll
            for (int ai = 0; ai < 2; ++ai) {
                u32x2 raw[4][2][2];
#pragma unroll
                for (int m = 0; m < 4; ++m) { const bf16_t* xb = XB + (size_t)(row0 + ai * HALF + m * 16) * D + col0;
#pragma unroll
                    for (int bj = 0; bj < 2; ++bj)
#pragma unroll
                        for (int n = 0; n < 2; ++n) raw[m][bj][n] = *(const u32x2*)(xb + bj * HALF + n * 16); }
#pragma unroll
                for (int m = 0; m < 4; ++m) { const int row = row0 + ai * HALF + m * 16; bf16_t* xb = XB + (size_t)row * D + col0; float q = 0.f;
#pragma unroll
                    for (int bj = 0; bj < 2; ++bj)
#pragma unroll
                        for (int n = 0; n < 2; ++n) { const u32x2 w = raw[m][bj][n];
                            const f32x4 xo = (f32x4){__builtin_bit_cast(float, w.x << 16), __builtin_bit_cast(float, w.x & 0xffff0000u), __builtin_bit_cast(float, w.y << 16), __builtin_bit_cast(float, w.y & 0xffff0000u)};
                            const f32x4 x = xo + acc[ai][bj][m][n] * c;
                            if (mode == 1) *(f32x4*)(xs + (ai * HALF + m * 16) * 256 + bj * HALF + n * 16) = x;
                            else q += store_round(xb + bj * HALF + n * 16, x); }
                    q += __shfl_xor(q, 16); q += __shfl_xor(q, 32);
                    if (fq == 0 && mode != 1) ssn[(size_t)row * 16 + u.pn * 4 + wc] = q; }
                asm volatile("" ::: "memory");
            }
        }
    }
};

struct EpiMix {
    static constexpr bool PERM = true, AFTER_DRAIN = false;
    bf16_t* ZB; float* GB; const float* ss; const float* lb;
    __device__ __forceinline__ void operator()(const f32x4 (&acc)[2][2][4][2], const Unit& u, int wr, int wc, int fr, int fq) const {
        const int row0 = u.pm * BM + wr * 64 + fr; const int seg = u.pn >> 1; const int cs0 = (u.pn & 1) * BM + wc * 32 + 8 * fq;
        if (seg == 1) {
#pragma unroll
            for (int bj = 0; bj < 2; ++bj) {
                const int cs = cs0 + bj * HALF;
                const f32x4 l0 = *(const f32x4*)(lb + cs), l1 = *(const f32x4*)(lb + cs + 4);
#pragma unroll
                for (int ai = 0; ai < 2; ++ai)
#pragma unroll
                    for (int m = 0; m < 4; ++m) {
                        const int row = row0 + ai * HALF + m * 16;
                        const float rstd = row_rstd(ss, row);
                        float kk[8], gg[8];
#pragma unroll
                        for (int e = 0; e < 8; ++e) {
                            const float z = (e < 4 ? acc[ai][bj][m][0][e & 3] : acc[ai][bj][m][1][e & 3]) * rstd;
                            const float lbv = e < 4 ? l0[e & 3] : l1[e & 3];
                            const float e2 = __expf(-fabsf(z)); const float r = __builtin_amdgcn_rcpf(1.f + e2);
                            const float sp = z >= 0.f ? r : e2 * r;
                            const float sm = z >= 0.f ? e2 * r : r;
                            kk[e] = (1.f - lbv) * sm;
                            gg[e] = __logf(lbv + (1.f - lbv) * sp);
                        }
                        u32x4 w; w.x = cvt_pk_bf16(kk[0], kk[1]); w.y = cvt_pk_bf16(kk[2], kk[3]); w.z = cvt_pk_bf16(kk[4], kk[5]); w.w = cvt_pk_bf16(kk[6], kk[7]);
                        *(u32x4*)(ZB + (size_t)row * INC + 512 + cs) = w;
                        *(f32x4*)(GB + (size_t)row * 512 + cs) = (f32x4){gg[0], gg[1], gg[2], gg[3]};
                        *(f32x4*)(GB + (size_t)row * 512 + cs + 4) = (f32x4){gg[4], gg[5], gg[6], gg[7]};
                    }
            }
        } else {
            const bool act = (seg == 0) || (seg == 3);
#pragma unroll
            for (int ai = 0; ai < 2; ++ai)
#pragma unroll
                for (int m = 0; m < 4; ++m) {
                    const int row = row0 + ai * HALF + m * 16;
                    const float rstd = row_rstd(ss, row);
#pragma unroll
                    for (int bj = 0; bj < 2; ++bj) {
                        f32x4 z0 = acc[ai][bj][m][0] * rstd, z1 = acc[ai][bj][m][1] * rstd;
                        if (act) {
#pragma unroll
                            for (int e = 0; e < 4; ++e) { z0[e] = silu_f(z0[e]); z1[e] = silu_f(z1[e]); }
                        }
                        u32x4 w; w.x = cvt_pk_bf16(z0[0], z0[1]); w.y = cvt_pk_bf16(z0[2], z0[3]); w.z = cvt_pk_bf16(z1[0], z1[1]); w.w = cvt_pk_bf16(z1[2], z1[3]);
                        *(u32x4*)(ZB + (size_t)row * INC + seg * 512 + cs0 + bj * HALF) = w;
                    }
                }
        }
    }
};

template <class Epi, class Sched, bool ALIGN_EPI = false, bool SP2 = false>
__device__ __forceinline__ void gemm_phase(LAS unsigned char* lds, const Gemm g, const Sched& S, const Epi& E, const int tid) {
    const int wid = __builtin_amdgcn_readfirstlane(tid >> 6), lane = tid & 63, wr = wid >> 2, wc = wid & 3, fr = lane & 15, fq = lane >> 4;
    const int K = g.K, nt = g.nt;
    unsigned voffA[2], voffB[2];
#pragma unroll
    for (int i = 0; i < 2; ++i) { int R, C; stage_rc(tid * 16 + i * 8192, R, C); const int Rb = Epi::PERM ? ((R & ~31) + perm32(R & 31)) : R;
        voffA[i] = (unsigned)(R * K + C) * 2u; voffB[i] = (unsigned)(Rb * K + C) * 2u; }
    const size_t kstep = (size_t)(BK * 2);
    const size_t hstep = (size_t)HALF * K * 2;
    const size_t tstep = 2 * hstep;
    const unsigned ldsw = (unsigned)wid * 1024u;
    const int aoff = lds_byte(wr * 64 + fr, fq * 8), boff = lds_byte(wc * 32 + fr, fq * 8);
#define PG8_SA(b, h) (((b) * 2 + (h)) * HTB)
#define PG8_SB(b, h) ((4 + (b) * 2 + (h)) * HTB)
#define PG8_STAGE(bufoff, gbase, voff) do { _Pragma("unroll") for (int _i = 0; _i < 2; ++_i) \
        __builtin_amdgcn_global_load_lds((const unsigned*)((const char*)(gbase) + (voff)[_i]), (LAS unsigned*)(lds + (bufoff) + ldsw + _i * 8192), 16, 0, 0); } while (0)
#define PG8_LDA(dst, b, h) do { _Pragma("unroll") for (int m = 0; m < 4; ++m) _Pragma("unroll") for (int k = 0; k < 2; ++k) dst[m][k] = *(const LAS bf16x8*)(lds + PG8_SA(b, h) + aoff + m * 2048 + k * 1024); } while (0)
#define PG8_LDB(dst, b, h) do { _Pragma("unroll") for (int n = 0; n < 2; ++n) _Pragma("unroll") for (int k = 0; k < 2; ++k) dst[n][k] = *(const LAS bf16x8*)(lds + PG8_SB(b, h) + boff + n * 2048 + k * 1024); } while (0)
#define PG8_MMA(ai, bj, At, Bt) do { __builtin_amdgcn_s_setprio(1); _Pragma("unroll") for (int m = 0; m < 4; ++m) _Pragma("unroll") for (int n = 0; n < 2; ++n) _Pragma("unroll") for (int k = 0; k < 2; ++k) \
        acc[ai][bj][m][n] = __builtin_amdgcn_mfma_f32_16x16x32_bf16(Bt[n][k], At[m][k], acc[ai][bj][m][n], 0, 0, 0); __builtin_amdgcn_s_setprio(0); } while (0)
#define PG8_WAIT_V(n) asm volatile("s_waitcnt vmcnt(" #n ")" ::: "memory")
#define PG8_WAIT_L(n) asm volatile("s_waitcnt lgkmcnt(" #n ")" ::: "memory")
#define PG8_BAR __builtin_amdgcn_s_barrier()
#define PG8_SCHED __builtin_amdgcn_sched_barrier(0)
    Unit cur, nxt; int ui = 0;
    if (!S.next(0, cur)) return;
    f32x4 acc[2][2][4][2];
#pragma unroll
    for (int a = 0; a < 2; ++a)
#pragma unroll
        for (int b = 0; b < 2; ++b)
#pragma unroll
            for (int m = 0; m < 4; ++m)
#pragma unroll
                for (int n = 0; n < 2; ++n) acc[a][b][m][n] = (f32x4){0.f, 0.f, 0.f, 0.f};
    bf16x8 At[4][2], B0[2][2], B1[2][2];
    const char* gA = (const char*)g.A + g.koff; const char* gB = (const char*)g.Bt + g.koff;
    const char* cA = gA + (size_t)cur.pm * tstep; const char* cB = gB + (size_t)cur.pn * tstep;
    S.a_ready(cur);
    if constexpr (SP2) {
        PG8_STAGE(PG8_SB(0, 0), cB, voffB); PG8_STAGE(PG8_SB(0, 1), cB + hstep, voffB); PG8_STAGE(PG8_SA(0, 0), cA, voffA); PG8_STAGE(PG8_SA(0, 1), cA + hstep, voffA);
        if (wr == 1) PG8_BAR;
        PG8_WAIT_V(2); PG8_BAR;
        PG8_STAGE(PG8_SB(1, 0), cB + kstep, voffB); PG8_STAGE(PG8_SA(1, 0), cA + kstep, voffA); PG8_STAGE(PG8_SB(1, 1), cB + hstep + kstep, voffB);
        PG8_WAIT_V(6); PG8_BAR;
    } else {
        PG8_STAGE(PG8_SB(0, 0), cB, voffB); PG8_STAGE(PG8_SA(0, 0), cA, voffA); PG8_STAGE(PG8_SB(0, 1), cB + hstep, voffB); PG8_STAGE(PG8_SA(0, 1), cA + hstep, voffA);
        if (wr == 1) PG8_BAR;
        PG8_WAIT_V(4); PG8_BAR;
        PG8_STAGE(PG8_SB(1, 0), cB + kstep, voffB); PG8_STAGE(PG8_SA(1, 0), cA + kstep, voffA); PG8_STAGE(PG8_SB(1, 1), cB + hstep + kstep, voffB);
        PG8_WAIT_V(6); PG8_BAR;
    }
    for (;;) {
        const bool has_next = S.next(ui + 1, nxt);
        const char* nA = has_next ? gA + (size_t)nxt.pm * tstep : cA; const char* nB = has_next ? gB + (size_t)nxt.pn * tstep : cB;
        for (int t = 0; t < nt; t += 2) {
            const bool last = (t == nt - 2);
            const char* a1 = cA + (size_t)(t + 1) * kstep;
            const char* a2 = last ? nA : cA + (size_t)(t + 2) * kstep; const char* b2 = last ? nB : cB + (size_t)(t + 2) * kstep;
            const char* a3 = a2 + kstep; const char* b3 = b2 + kstep;
            if (last && has_next) S.a_ready(nxt);
            if constexpr (SP2) {
            PG8_LDB(B0, 0, 0); PG8_LDB(B1, 0, 1); PG8_SCHED; PG8_LDA(At, 0, 0); PG8_STAGE(PG8_SA(1, 1), a1 + hstep, voffA);
            PG8_WAIT_V(8); PG8_WAIT_L(0); PG8_BAR; PG8_MMA(0, 0, At, B0); PG8_MMA(0, 1, At, B1); PG8_BAR; PG8_SCHED;
            PG8_LDA(At, 0, 1); PG8_STAGE(PG8_SB(0, 0), b2, voffB); PG8_STAGE(PG8_SB(0, 1), b2 + hstep, voffB); PG8_STAGE(PG8_SA(0, 0), a2, voffA);
            PG8_WAIT_V(8); PG8_WAIT_L(0); PG8_BAR; PG8_MMA(1, 0, At, B0); PG8_MMA(1, 1, At, B1); PG8_BAR; PG8_SCHED;
            PG8_LDB(B0, 1, 0); PG8_LDB(B1, 1, 1); PG8_SCHED; PG8_LDA(At, 1, 0); PG8_STAGE(PG8_SA(0, 1), a2 + hstep, voffA);
            PG8_WAIT_V(8); PG8_WAIT_L(0); PG8_BAR; PG8_MMA(0, 0, At, B0); PG8_MMA(0, 1, At, B1); PG8_BAR; PG8_SCHED;
            PG8_LDA(At, 1, 1); PG8_STAGE(PG8_SB(1, 0), b3, voffB); PG8_STAGE(PG8_SB(1, 1), b3 + hstep, voffB); PG8_STAGE(PG8_SA(1, 0), a3, voffA);
            PG8_WAIT_V(8); PG8_WAIT_L(0); PG8_BAR; PG8_MMA(1, 0, At, B0); PG8_MMA(1, 1, At, B1); PG8_BAR; PG8_SCHED;
            } else {
            PG8_LDB(B0, 0, 0); PG8_SCHED; PG8_LDA(At, 0, 0); PG8_STAGE(PG8_SA(1, 1), a1 + hstep, voffA);
            PG8_WAIT_L(8); PG8_BAR; PG8_WAIT_L(0); PG8_MMA(0, 0, At, B0); PG8_BAR; PG8_SCHED;
            PG8_LDB(B1, 0, 1); PG8_STAGE(PG8_SB(0, 0), b2, voffB);
            PG8_BAR; PG8_WAIT_L(0); PG8_MMA(0, 1, At, B1); PG8_BAR;
            PG8_LDA(At, 0, 1); PG8_STAGE(PG8_SA(0, 0), a2, voffA);
            PG8_BAR; PG8_WAIT_L(0); PG8_MMA(1, 0, At, B0); PG8_BAR; PG8_SCHED;
            PG8_STAGE(PG8_SB(0, 1), b2 + hstep, voffB);
            PG8_WAIT_V(6); PG8_BAR; PG8_MMA(1, 1, At, B1); PG8_BAR;
            PG8_LDB(B0, 1, 0); PG8_SCHED; PG8_LDA(At, 1, 0); PG8_STAGE(PG8_SA(0, 1), a2 + hstep, voffA);
            PG8_WAIT_L(8); PG8_BAR; PG8_WAIT_L(0); PG8_MMA(0, 0, At, B0); PG8_BAR; PG8_SCHED;
            PG8_LDB(B1, 1, 1); PG8_STAGE(PG8_SB(1, 0), b3, voffB);
            PG8_BAR; PG8_WAIT_L(0); PG8_MMA(0, 1, At, B1); PG8_BAR;
            PG8_LDA(At, 1, 1); PG8_STAGE(PG8_SA(1, 0), a3, voffA);
            PG8_BAR; PG8_WAIT_L(0); PG8_MMA(1, 0, At, B0); PG8_BAR; PG8_SCHED;
            PG8_STAGE(PG8_SB(1, 1), b3 + hstep, voffB);
            PG8_WAIT_V(6); PG8_BAR; PG8_MMA(1, 1, At, B1); PG8_BAR;
            }
        }
        if constexpr (ALIGN_EPI) { if (wr == 0) PG8_BAR; }
        if constexpr (!Epi::AFTER_DRAIN) { E(acc, cur, wr, wc, fr, fq); S.done(cur); }
        if (!has_next) break;
#pragma unroll
        for (int a = 0; a < 2; ++a)
#pragma unroll
            for (int b = 0; b < 2; ++b)
#pragma unroll
                for (int m = 0; m < 4; ++m)
#pragma unroll
                    for (int n = 0; n < 2; ++n) acc[a][b][m][n] = (f32x4){0.f, 0.f, 0.f, 0.f};
        cur = nxt; cA = nA; cB = nB; ++ui;
        if constexpr (ALIGN_EPI) { if (wr == 1) PG8_BAR; }
    }
    PG8_WAIT_V(0);
    if constexpr (!ALIGN_EPI) { if (wr == 0) PG8_BAR; }
    PG8_BAR;
#undef PG8_SA
#undef PG8_SB
#undef PG8_STAGE
#undef PG8_LDA
#undef PG8_LDB
#undef PG8_MMA
#undef PG8_WAIT_V
#undef PG8_WAIT_L
#undef PG8_BAR
#undef PG8_SCHED
}
}

#define XB_TMO      128
#define XB_XCNT(j)  (256  + 64 * (j))
#define XB_XSUB(j)  (1280 + 64 * (j))
#define XB_XGEN(j)  (2304 + 64 * (j))
#define XB_TOP      3328
#define XB_TOPGEN   3392
#define XCD_BAR_WORDS 3456
#define XB_SPIN_CAP (1u << 22)
__device__ __forceinline__ unsigned xb_ld(unsigned* p)              { return __hip_atomic_load(p, __ATOMIC_RELAXED, __HIP_MEMORY_SCOPE_AGENT); }
__device__ __forceinline__ unsigned xb_add(unsigned* p, unsigned v) { return __hip_atomic_fetch_add(p, v, __ATOMIC_RELAXED, __HIP_MEMORY_SCOPE_AGENT); }
__device__ __forceinline__ unsigned xb_xcc_id() { return (unsigned)__builtin_amdgcn_s_getreg((3 << 11) | 20) & 0xFu; }
#define XB_SPIN(cond, bar) do { unsigned _sp = 0; while (cond) { __builtin_amdgcn_s_sleep(1); \
    if ((++_sp & 255u) == 0u) { if (xb_ld(&(bar)[XB_TMO])) break; if (_sp > XB_SPIN_CAP) { atomicAdd(&(bar)[XB_TMO], 1u); break; } } } } while (0)
struct XcdBarrier { unsigned* bar; unsigned x; volatile LAS unsigned* st; };
__device__ __forceinline__ XcdBarrier xcd_barrier_post(unsigned* bar, volatile LAS unsigned* st) {
    XcdBarrier b; b.bar = bar; b.x = xb_xcc_id(); b.st = st;
    if (threadIdx.x == 0) (void)xb_add(&bar[XB_XCNT(b.x)], 1u);
    return b;
}
__device__ __forceinline__ void xcd_barrier_complete(unsigned* bar, unsigned x, unsigned& nloc, unsigned& nx) {
    const unsigned G = gridDim.x * gridDim.y * gridDim.z;
    unsigned sum, cnt, mine, sp = 0u;
    for (;;) {
        sum = 0u; cnt = 0u; mine = 0u;
#pragma unroll
        for (unsigned j = 0; j < 16; ++j) { const unsigned c = xb_ld(&bar[XB_XCNT(j)]); sum += c; cnt += (c > 0u) ? 1u : 0u; mine = (j == x) ? c : mine; }
        if (sum == G) break;
        __builtin_amdgcn_s_sleep(1);
        if ((++sp & 255u) == 0u) { if (xb_ld(&bar[XB_TMO])) break; if (sp > XB_SPIN_CAP) { atomicAdd(&bar[XB_TMO], 1u); break; } }
    }
    nloc = mine > 0u ? mine : 1u; nx = cnt > 0u ? cnt : 1u;
}
__device__ __forceinline__ void xcd_barrier(const XcdBarrier& b) {
    asm volatile("s_waitcnt vmcnt(0)" ::: "memory");
    __syncthreads();
    if (threadIdx.x == 0) {
        unsigned* bar = b.bar;
        __builtin_amdgcn_s_waitcnt(0);
        unsigned nloc = b.st[0], nx = b.st[1];
        if (nloc == 0u) { xcd_barrier_complete(bar, b.x, nloc, nx); b.st[0] = nloc; b.st[1] = nx; }
        const unsigned old = xb_add(&bar[XB_XSUB(b.x)], 1u);
        const unsigned gen = old / nloc;
        if (old + 1u == (gen + 1u) * nloc) {
            __builtin_amdgcn_fence(__ATOMIC_RELEASE, "agent");
            asm volatile("s_waitcnt vmcnt(0)" ::: "memory");
            const unsigned og = xb_add(&bar[XB_TOP], 1u);
            const unsigned tg = og / nx;
            if (og + 1u == (tg + 1u) * nx) xb_add(&bar[XB_TOPGEN], 1u);
            else XB_SPIN(xb_ld(&bar[XB_TOPGEN]) == tg, bar);
            __builtin_amdgcn_fence(__ATOMIC_ACQUIRE, "agent");
            xb_add(&bar[XB_XGEN(b.x)], 1u);
            asm volatile("s_waitcnt vmcnt(0)" ::: "memory");
        } else {
            XB_SPIN(xb_ld(&bar[XB_XGEN(b.x)]) == gen, bar);
            __builtin_amdgcn_fence(__ATOMIC_ACQUIRE, "agent");
            asm volatile("s_waitcnt vmcnt(0)" ::: "memory");
        }
    }
    __syncthreads();
}

__device__ __forceinline__ void handoff_publish(unsigned* cnt) {
    asm volatile("s_waitcnt vmcnt(0)" ::: "memory");
    __syncthreads();
    if (threadIdx.x == 0) {
        __builtin_amdgcn_fence(__ATOMIC_RELEASE, "agent");
        asm volatile("s_waitcnt vmcnt(0)" ::: "memory");
        (void)xb_add(cnt, 1u);
    }
}
__device__ __forceinline__ void handoff_wait(unsigned* cnt, unsigned target) {
    unsigned sp = 0;
    while (xb_ld(cnt) < target) { __builtin_amdgcn_s_sleep(4); if (++sp > (1u << 24)) break; }
    __builtin_amdgcn_fence(__ATOMIC_ACQUIRE, "agent");
    asm volatile("s_waitcnt vmcnt(0)" ::: "memory");
}

struct Args { const float* in[19]; float* out; unsigned char* ws; int ph_lo, ph_hi; };
typedef const __attribute__((address_space(4))) Args* ArgsP;
enum { I_XP = 0, I_XS, I_SHG, I_SPOOL, I_META, I_LBL, I_N1, I_W1I, I_W1O, I_NM, I_WIN, I_HGN, I_PW, I_PS, I_WOUT, I_N2, I_W2I, I_W2O, I_NF };

__device__ __forceinline__ void conv_item(const float* W, int ldw, const float* kscale, const float* nscale, bf16_t* WT, int ldt, int drow0, int k0, int n0, LAS float* scr, int lane) {
    float wv[32];
#pragma unroll
    for (int i = 0; i < 32; ++i) wv[i] = W[(size_t)(k0 + 2 * i + (lane >> 5)) * ldw + n0 + (lane & 31)];
    const float ns = nscale ? nscale[n0 + (lane & 31)] : 1.f;
    float ksv[2];
    ksv[0] = kscale ? kscale[k0 + lane] : 1.f;
#pragma unroll
    for (int i = 0; i < 32; ++i) {
        const int kk = 2 * i + (lane >> 5), n = lane & 31;
        const float kv = __builtin_bit_cast(float, __builtin_amdgcn_ds_bpermute(kk << 2, __builtin_bit_cast(int, ksv[0])));
        scr[kk * 33 + n] = wv[i] * kv * ns;
    }
    asm volatile("s_waitcnt lgkmcnt(0)" ::: "memory");
    const int c = lane & 7;
#pragma unroll
    for (int j = 0; j < 4; ++j) {
        const int n = (lane >> 3) + 8 * j; const LAS float* s = scr + (8 * c) * 33 + n;
        u32x4 o; o.x = cvt_pk_bf16(s[0 * 33], s[1 * 33]); o.y = cvt_pk_bf16(s[2 * 33], s[3 * 33]); o.z = cvt_pk_bf16(s[4 * 33], s[5 * 33]); o.w = cvt_pk_bf16(s[6 * 33], s[7 * 33]);
        *(u32x4*)(WT + (size_t)(drow0 + n) * ldt + k0 + 8 * c) = o;
    }
    asm volatile("s_waitcnt lgkmcnt(0)" ::: "memory");
}

__device__ __forceinline__ void wconv_layer(ArgsP a, int l, bf16_t* ws_set, LAS float* scr, int gw, int NGW, int lane) {
    constexpr int I1 = 16 * 176, I2 = 44 * 32, I3 = 16 * 80, I4 = 16 * 32, I7 = 32;
    for (int it = gw; it < 2 * I1 + 2 * I2 + I3 + I4 + I7; it += NGW) {
        int r = it; const float* W; const float* ks = nullptr; const float* ns = nullptr; bf16_t* WT; int K, N; int mode = 0;
        if (r < I1) { W = a->in[I_W1I] + (size_t)l * D * FF2; ks = a->in[I_N1] + l * D; WT = ws_set + WO_1I; K = D; N = FF2; mode = 1; }
        else if ((r -= I1) < I2) { W = a->in[I_W1O] + (size_t)l * FF * D; WT = ws_set + WO_1O; K = FF; N = D; }
        else if ((r -= I2) < I3) { W = a->in[I_WIN] + (size_t)l * D * INC; ks = a->in[I_NM] + l * D; WT = ws_set + WO_IN; K = D; N = INC; }
        else if ((r -= I3) < I4) { W = a->in[I_WOUT] + (size_t)l * D * D; WT = ws_set + WO_OUT; K = D; N = D; }
        else if ((r -= I4) < I1) { W = a->in[I_W2I] + (size_t)l * D * FF2; ks = a->in[I_N2] + l * D; WT = ws_set + WO_2I; K = D; N = FF2; mode = 1; }
        else if ((r -= I1) < I2) { W = a->in[I_W2O] + (size_t)l * FF * D; WT = ws_set + WO_2O; K = FF; N = D; }
        else { r -= I2; const int g = r >> 3; r &= 7; W = a->in[I_PW] + (size_t)(l * 4 + g) * 16384; ns = a->in[I_PS] + l * 512 + g * 128; WT = ws_set + WO_PW + g * 16384; K = 128; N = 128; }
        const int nblk = N / 32, kb = r / nblk, nb = r % nblk, k0 = 64 * kb, n0 = 32 * nb;
        int drow0 = n0;
        if (mode == 1) { if (n0 < FF) drow0 = (n0 / 128) * 256 + (n0 % 128); else { const int j = n0 - FF; drow0 = (j / 128) * 256 + 128 + (j % 128); } }
        conv_item(W, N, ks, ns, WT, K, drow0, k0, n0, scr, lane);
    }
}

typedef short v4i16_t __attribute__((ext_vector_type(4)));
__device__ __forceinline__ bf16x8 tr_frag(const LAS bf16_t* tile, int stride, int s0, int v0, int r, int q) {
    const LAS bf16_t* p0 = tile + (s0 + 8 * q + (r >> 2)) * stride + v0 + 4 * (r & 3);
    const v4i16_t lo = __builtin_amdgcn_ds_read_tr16_b64_v4i16((LAS v4i16_t*)p0);
    const v4i16_t hi = __builtin_amdgcn_ds_read_tr16_b64_v4i16((LAS v4i16_t*)(p0 + 4 * stride));
    return (bf16x8){lo[0], lo[1], lo[2], lo[3], hi[0], hi[1], hi[2], hi[3]};
}

struct ChunkGeo { int b, h, c, L; size_t r0; };
__device__ __forceinline__ int chunk_slot(int wi) { return wi < 1024 ? (wi >> 5) * NCH + 1 + (wi & 31) : (wi - 1024) * NCH; }
__device__ __forceinline__ ChunkGeo chunk_geo(int it) {
    ChunkGeo g; const int bh = it / NCH; g.c = it - bh * NCH; g.b = bh >> 2; g.h = bh & 3;
    const int t0 = g.c == 0 ? 0 : NMETA + 64 * (g.c - 1); g.L = g.c == 0 ? NMETA : 64; g.r0 = (size_t)g.b * TP + t0; return g;
}

__device__ __forceinline__ void hgrn_local_item(int it, const bf16_t* ZB, const float* GB, bf16_t* CS, float* DEC, LAS unsigned char* lds, int tid) {
    const ChunkGeo G = chunk_geo(it);
    const int d = tid & 127, p = tid >> 7, lane = tid & 63, w = tid >> 6, r = lane & 15, q = lane >> 4;
    LAS float* TOT = (LAS float*)lds;
    LAS bf16_t* KDT = (LAS bf16_t*)(lds + 2048);
    LAS bf16_t* VS = (LAS bf16_t*)(lds + 20480);
    const bool pv = (16 * p < G.L);
    float bb[16]; unsigned short kraw[16]; u32x4 vv[2];
    const int prow = pv ? 16 * p : 0;
#pragma unroll
    for (int i = 0; i < 16; ++i) bb[i] = GB[(G.r0 + prow + i) * 512 + G.h * 128 + d];
#pragma unroll
    for (int i = 0; i < 16; ++i) kraw[i] = ZB[(G.r0 + prow + i) * INC + 512 + G.h * 128 + d];
#pragma unroll
    for (int e2 = 0; e2 < 2; ++e2) { const int e = tid + 512 * e2, s = e >> 4, ch = e & 15; const int sc = s < G.L ? s : 0;
        vv[e2] = *(const u32x4*)(ZB + (G.r0 + sc) * INC + 1024 + G.h * 128 + ch * 8); }
#pragma unroll
    for (int i = 0; i < 16; ++i) { bb[i] = pv ? bb[i] : 0.f; kraw[i] = pv ? kraw[i] : (unsigned short)0; }
#pragma unroll
    for (int e2 = 0; e2 < 2; ++e2) { const int e = tid + 512 * e2, s = e >> 4; if (s >= G.L) vv[e2] = (u32x4){0u, 0u, 0u, 0u}; }
    float run = 0.f;
#pragma unroll
    for (int i = 0; i < 16; ++i) { run += bb[i]; bb[i] = run; }
    TOT[p * 128 + d] = run;
#pragma unroll
    for (int e2 = 0; e2 < 2; ++e2) { const int e = tid + 512 * e2, s = e >> 4, ch = e & 15; *(LAS u32x4*)(VS + s * 136 + ch * 8) = vv[e2]; }
    __syncthreads();
    float off = 0.f, tot = 0.f;
#pragma unroll
    for (int pp = 0; pp < 4; ++pp) { const float tv = TOT[pp * 128 + d]; if (pp < p) off += tv; tot += tv; }
    unsigned kd[8];
#pragma unroll
    for (int i = 0; i < 16; i += 2) {
        const float k0 = bf2f(kraw[i]), k1 = bf2f(kraw[i + 1]);
        kd[i >> 1] = cvt_pk_bf16(k0 * __expf(tot - (bb[i] + off)), k1 * __expf(tot - (bb[i + 1] + off)));
    }
    *(LAS u32x4*)(KDT + d * 72 + 16 * p) = (u32x4){kd[0], kd[1], kd[2], kd[3]};
    *(LAS u32x4*)(KDT + d * 72 + 16 * p + 8) = (u32x4){kd[4], kd[5], kd[6], kd[7]};
    if (p == 0) DEC[(size_t)it * 128 + d] = __expf(tot);
    __syncthreads();
    bf16x8 vf[2];
#pragma unroll
    for (int ks = 0; ks < 2; ++ks) vf[ks] = tr_frag(VS, 136, 32 * ks, 16 * w, r, q);
    bf16_t* cs = CS + (size_t)it * 16384;
#pragma unroll
    for (int dt = 0; dt < 8; ++dt) {
        f32x4 acc = (f32x4){0.f, 0.f, 0.f, 0.f};
#pragma unroll
        for (int ks = 0; ks < 2; ++ks) { const bf16x8 kf = *(const LAS bf16x8*)(KDT + (16 * dt + r) * 72 + 32 * ks + 8 * q); acc = __builtin_amdgcn_mfma_f32_16x16x32_bf16(kf, vf[ks], acc, 0, 0, 0); }
        { u32x2 wv; wv.x = cvt_pk_bf16(acc[0], acc[1]); wv.y = cvt_pk_bf16(acc[2], acc[3]); *(u32x2*)(cs + (16 * w + r) * 128 + 16 * dt + 4 * q) = wv; }
    }
    __syncthreads();
}

__device__ __forceinline__ void sample_item(int its, int l, ArgsP a, const bf16_t* ZB, const float* GB, bf16_t* MIX, LAS unsigned char* lds, int tid) {
    const int b = its >> 2, h = its & 3; const size_t row0 = (size_t)MP + 4 * b;
    const int lane = tid & 63, wave = tid >> 6;
    LAS float* QKF = (LAS float*)lds;
    LAS float* VG = (LAS float*)(lds + 6144);
    LAS float* OP = (LAS float*)(lds + 10240);
    LAS float* RS = (LAS float*)(lds + 18432);
    {
        const int t = tid >> 7, d = tid & 127; const bf16_t* zr = ZB + (row0 + t) * INC + h * 128 + d;
        QKF[(0 * 4 + t) * 128 + d] = bf2f(zr[0]); QKF[(1 * 4 + t) * 128 + d] = bf2f(zr[512]);
        QKF[(2 * 4 + t) * 128 + d] = __expf(GB[(row0 + t) * 512 + h * 128 + d]);
        VG[(0 * 4 + t) * 128 + d] = bf2f(zr[1024]); VG[(1 * 4 + t) * 128 + d] = bf2f(zr[1536]);
    }
    const int v = tid & 127, dq = tid >> 7;
    float S[32];
    const size_t sbase = (((size_t)l * DBATCH + b) * NH + h) * 16384 + (size_t)(32 * dq) * 128 + v;
    const float* sp = a->in[I_SHG] + sbase;
#pragma unroll
    for (int i = 0; i < 32; ++i) S[i] = sp[i * 128];
    __syncthreads();
#pragma unroll
    for (int t = 0; t < 4; ++t) {
        const float vt = VG[(0 * 4 + t) * 128 + v]; float acc = 0.f;
        const float fq_ = QKF[(2 * 4 + t) * 128 + 32 * dq + (lane & 31)], kq_ = QKF[(1 * 4 + t) * 128 + 32 * dq + (lane & 31)], qq_ = QKF[(0 * 4 + t) * 128 + 32 * dq + (lane & 31)];
#pragma unroll
        for (int i = 0; i < 32; ++i) {
            const float fi = __builtin_bit_cast(float, __builtin_amdgcn_readlane(__builtin_bit_cast(int, fq_), i));
            const float ki = __builtin_bit_cast(float, __builtin_amdgcn_readlane(__builtin_bit_cast(int, kq_), i));
            const float qi = __builtin_bit_cast(float, __builtin_amdgcn_readlane(__builtin_bit_cast(int, qq_), i));
            S[i] = fi * S[i] + ki * vt; acc += qi * S[i]; }
        OP[(dq * 4 + t) * 128 + v] = acc;
    }
    float* so = a->out + O_HGS + sbase;
#pragma unroll
    for (int i = 0; i < 32; ++i) so[i * 128] = S[i];
    __syncthreads();
    {
        const int t = tid >> 7;
        const float ov = OP[(0 * 4 + t) * 128 + v] + OP[(1 * 4 + t) * 128 + v] + OP[(2 * 4 + t) * 128 + v] + OP[(3 * 4 + t) * 128 + v];
        const float sq = wave_sum(ov * ov);
        if (lane == 0) RS[wave] = sq;
        __syncthreads();
        const float tot = RS[wave & ~1] + RS[wave | 1];
        const float rn = rsqrtf(tot * (1.f / 128.f) + EPS);
        const float o = ov * rn * a->in[I_HGN][l * 512 + h * 128 + v] * VG[(1 * 4 + t) * 128 + v];
        MIX[(row0 + t) * D + h * 128 + v] = (DBG_MASK & 4) ? (bf16_t)0 : (bf16_t)f2bf(o);
    }
    __syncthreads();
}

__device__ __forceinline__ void pool_item(int ip, int l, ArgsP a, const bf16_t* ZB, const bf16_t* PWT, bf16_t* MIX, LAS unsigned char* lds, int tid) {
    const int cc = tid & 127, p = tid >> 7, lane = tid & 63, w8 = tid >> 6, r = lane & 15, q = lane >> 4;
    LAS bf16_t* DA = (LAS bf16_t*)lds;
    float dd[2][16]; int g0, L; size_t rowbase;
    const char* zbb = (const char*)ZB; const char* spb = (const char*)a->in[I_SPOOL]; char* outb = (char*)a->out;
    if (ip < NB * NCH * 2) {
        const int b = ip / (NCH * 2), rem = ip - b * (NCH * 2), c = rem >> 1; g0 = (rem & 1) * 2;
        const int t0 = c == 0 ? 0 : NMETA + 64 * (c - 1); L = c == 0 ? NMETA : 64; rowbase = (size_t)b * TP + t0;
        const bool pv = 16 * p < L;
        float uu[2][31];
#pragma unroll
        for (int gi = 0; gi < 2; ++gi)
#pragma unroll
            for (int j = 0; j < 31; ++j) { const int t = t0 + 16 * p - 15 + j; const int tc = (pv && t >= 0) ? t : 0;
                const unsigned boff = (unsigned)(((b * TP + tc) * INC + 2048 + (g0 + gi) * 128 + cc) * 2);
                uu[gi][j] = bf2f(*(const unsigned short*)(zbb + boff)); }
#pragma unroll
        for (int gi = 0; gi < 2; ++gi) {
            const int g = g0 + gi, w = 2 << g;
#pragma unroll
            for (int j = 0; j < 31; ++j) { const int t = t0 + 16 * p - 15 + j; uu[gi][j] = (pv && t >= 0) ? uu[gi][j] : 0.f; }
#pragma unroll
            for (int i = 0; i < 16; ++i) {
                const int t = t0 + 16 * p + i; float s = 0.f;
#pragma unroll
                for (int j = 0; j < 16; ++j) if (j < w) s += uu[gi][15 + i - j];
                const float cnt = (float)min(w, t + 1);
                dd[gi][i] = pv ? (s / cnt - uu[gi][15 + i]) : 0.f;
                if (c == NCH - 1) { const int jj = t - (TP - PST); if (jj >= 0) *(float*)(outb + (unsigned)((O_POOLP + ((l * NB + b) * PST + jj) * 512 + g * 128 + cc) * 4)) = uu[gi][15 + i]; }
            }
        }
    } else {
        const int is = ip - NB * NCH * 2; const int sb = is >> 1; g0 = (is & 1) * 2; L = 64; rowbase = (size_t)MP + 64 * sb;
#pragma unroll
        for (int gi = 0; gi < 2; ++gi) {
            const int g = g0 + gi, w = 2 << g; const float invw = 1.f / (float)w;
#pragma unroll
            for (int bi = 0; bi < 4; ++bi) {
                const int bb = 16 * sb + 4 * p + bi; float ext[19];
#pragma unroll
                for (int j = 0; j < 15; ++j) ext[j] = *(const float*)(spb + (unsigned)((((l * DBATCH + bb) * PST + j) * 512 + g * 128 + cc) * 4));
#pragma unroll
                for (int t = 0; t < 4; ++t) ext[15 + t] = bf2f(*(const unsigned short*)(zbb + (unsigned)(((MP + 4 * bb + t) * INC + 2048 + g * 128 + cc) * 2)));
#pragma unroll
                for (int t = 0; t < 4; ++t) { float s = 0.f;
#pragma unroll
                    for (int j = 0; j < 16; ++j) if (j < w) s += ext[15 + t - j];
                    dd[gi][4 * bi + t] = s * invw - ext[15 + t]; }
#pragma unroll
                for (int j = 0; j < 15; ++j) *(float*)(outb + (unsigned)((O_POOLS + ((l * DBATCH + bb) * PST + j) * 512 + g * 128 + cc) * 4)) = ext[4 + j];
            }
        }
    }
#pragma unroll
    for (int gi = 0; gi < 2; ++gi)
#pragma unroll
        for (int i = 0; i < 16; ++i) DA[(gi * 64 + 16 * p + i) * 136 + cc] = (bf16_t)f2bf(dd[gi][i]);
    __syncthreads();
#pragma unroll
    for (int gi = 0; gi < 2; ++gi) {
        const int g = g0 + gi;
        bf16x8 bfr[4];
#pragma unroll
        for (int ks = 0; ks < 4; ++ks) bfr[ks] = *(const bf16x8*)(PWT + (size_t)g * 16384 + (16 * w8 + r) * 128 + 32 * ks + 8 * q);
#pragma unroll
        for (int tt = 0; tt < 4; ++tt) {
            f32x4 acc = (f32x4){0.f, 0.f, 0.f, 0.f};
#pragma unroll
            for (int ks = 0; ks < 4; ++ks) { const bf16x8 af = *(const LAS bf16x8*)(DA + (gi * 64 + 16 * tt + r) * 136 + 32 * ks + 8 * q); acc = __builtin_amdgcn_mfma_f32_16x16x32_bf16(bfr[ks], af, acc, 0, 0, 0); }
            if (16 * tt + r < L) { u32x2 wv; wv.x = cvt_pk_bf16(acc[0], acc[1]); wv.y = cvt_pk_bf16(acc[2], acc[3]);
                *(u32x2*)(MIX + (rowbase + 16 * tt + r) * D + 512 + g * 128 + 16 * w8 + 4 * q) = wv; }
        }
    }
    __syncthreads();
}

__device__ __forceinline__ void hgrn_scan(int l, ArgsP a, const bf16_t* CS, bf16_t* SB, const float* DEC, int gt, int ngt) {
    for (int idx = gt; idx < NB * NH * 128 * 32; idx += ngt) {
        const int d4 = idx & 31, v = (idx >> 5) & 127, bh = idx >> 12;
        f32x4 S = (f32x4){0.f, 0.f, 0.f, 0.f};
        const bf16_t* cs = CS + (size_t)bh * NCH * 16384 + v * 128 + 4 * d4; const float* dc = DEC + (size_t)bh * NCH * 128 + 4 * d4;
        bf16_t* sb = SB + (size_t)bh * NCH * 16384 + v * 128 + 4 * d4;
#pragma unroll 1
        for (int c0 = 0; c0 < NCH; c0 += 11) {
            f32x4 loc[11], de[11];
#pragma unroll
            for (int j = 0; j < 11; ++j) { const u32x2 w = *(const u32x2*)(cs + (size_t)(c0 + j) * 16384); de[j] = *(const f32x4*)(dc + (c0 + j) * 128);
                loc[j] = (f32x4){__builtin_bit_cast(float, w.x << 16), __builtin_bit_cast(float, w.x & 0xffff0000u), __builtin_bit_cast(float, w.y << 16), __builtin_bit_cast(float, w.y & 0xffff0000u)}; }
#pragma unroll
            for (int j = 0; j < 11; ++j) {
                u32x2 w; w.x = cvt_pk_bf16(S[0], S[1]); w.y = cvt_pk_bf16(S[2], S[3]);
                *(u32x2*)(sb + (size_t)(c0 + j) * 16384) = w;
                S = de[j] * S + loc[j];
            }
        }
        float* o = a->out + O_HGP + ((size_t)l * NB * NH + bh) * 16384 + (size_t)(4 * d4) * 128 + v;
        o[0] = S[0]; o[128] = S[1]; o[256] = S[2]; o[384] = S[3];
    }
}

__device__ __forceinline__ void hgrn_out_item(int it, int l, ArgsP a, const bf16_t* ZB, const float* GB, const bf16_t* SB, bf16_t* MIX, LAS unsigned char* lds, int tid) {
    const ChunkGeo G = chunk_geo(it);
    const int d = tid & 127, p = tid >> 7, lane = tid & 63, w = tid >> 6, r = lane & 15, q = lane >> 4;
    LAS float* TOT = (LAS float*)lds;
    LAS float* RR = (LAS float*)(lds + 2048);
    LAS float* RS = (LAS float*)(lds + 4096);
    LAS bf16_t* QS = (LAS bf16_t*)(lds + 6144);
    LAS bf16_t* QE = (LAS bf16_t*)(lds + 23552);
    LAS bf16_t* VS = (LAS bf16_t*)(lds + 40960);
    LAS bf16_t* PP = (LAS bf16_t*)(lds + 58368);
    LAS bf16_t* KS = (LAS bf16_t*)(lds + 67584);
    const bool pv = (16 * p < G.L);
    float bb[16]; unsigned short qraw[16], kraw[16]; u32x4 vv[2]; bf16x8 sf[4]; u32x2 graw[4];
    const int prow = pv ? 16 * p : 0;
#pragma unroll
    for (int i = 0; i < 16; ++i) bb[i] = GB[(G.r0 + prow + i) * 512 + G.h * 128 + d];
#pragma unroll
    for (int i = 0; i < 16; ++i) { qraw[i] = ZB[(G.r0 + prow + i) * INC + G.h * 128 + d]; kraw[i] = ZB[(G.r0 + prow + i) * INC + 512 + G.h * 128 + d]; }
#pragma unroll
    for (int e2 = 0; e2 < 2; ++e2) { const int e = tid + 512 * e2, s = e >> 4, ch = e & 15; const int sc = s < G.L ? s : 0;
        vv[e2] = *(const u32x4*)(ZB + (G.r0 + sc) * INC + 1024 + G.h * 128 + ch * 8); }
    {
        const bf16_t* st = SB + (size_t)it * 16384 + (16 * w + r) * 128 + 8 * q;
#pragma unroll
        for (int ks = 0; ks < 4; ++ks) sf[ks] = *(const bf16x8*)(st + 32 * ks);
    }
#pragma unroll
    for (int tt = 0; tt < 4; ++tt) { const int tc = (16 * tt + r < G.L) ? 16 * tt + r : 0; graw[tt] = *(const u32x2*)(ZB + (G.r0 + tc) * INC + 1536 + G.h * 128 + 16 * w + 4 * q); }
#pragma unroll
    for (int i = 0; i < 16; ++i) { bb[i] = pv ? bb[i] : 0.f; qraw[i] = pv ? qraw[i] : (unsigned short)0; kraw[i] = pv ? kraw[i] : (unsigned short)0; }
#pragma unroll
    for (int e2 = 0; e2 < 2; ++e2) { const int e = tid + 512 * e2, s = e >> 4; if (s >= G.L) vv[e2] = (u32x4){0u, 0u, 0u, 0u}; }
    float run = 0.f;
#pragma unroll
    for (int i = 0; i < 16; ++i) { run += bb[i]; bb[i] = run; }
    TOT[p * 128 + d] = run;
#pragma unroll
    for (int e2 = 0; e2 < 2; ++e2) { const int e = tid + 512 * e2, s = e >> 4, ch = e & 15; *(LAS u32x4*)(VS + s * 136 + ch * 8) = vv[e2]; }
    __syncthreads();
    float off = 0.f;
#pragma unroll
    for (int pp = 0; pp < 4; ++pp) { const float tv = TOT[pp * 128 + d]; if (pp < p) off += tv; }
#pragma unroll
    for (int i = 0; i < 16; ++i) bb[i] += off;
    RR[p * 128 + d] = bb[0];
#pragma unroll
    for (int i = 0; i < 16; ++i) {
        const float qv = bf2f(qraw[i]);
        QS[(16 * p + i) * 136 + d] = (bf16_t)f2bf(qv * __expf(bb[i] - bb[0]));
        QE[(16 * p + i) * 136 + d] = (bf16_t)f2bf(qv * __expf(bb[i]));
    }
    float kv[16];
#pragma unroll
    for (int i = 0; i < 16; ++i) kv[i] = bf2f(kraw[i]);
    __syncthreads();
#pragma unroll
    for (int I = 0; I < 4; ++I) {
        if (I >= p) {
            const float ref = RR[I * 128 + d]; const int base = 8 * I * (I + 1);
#pragma unroll
            for (int i = 0; i < 16; ++i) KS[(base + 16 * p + i) * 136 + d] = (bf16_t)f2bf(kv[i] * __expf(ref - bb[i]));
        }
    }
    __syncthreads();
#pragma unroll
    for (int h2 = 0; h2 < 2; ++h2) {
        const int id = w + 8 * h2, I = id >> 2, J = id & 3;
        f32x4 acc = (f32x4){0.f, 0.f, 0.f, 0.f};
        if (J <= I) {
#pragma unroll
            for (int ks = 0; ks < 4; ++ks) {
                const bf16x8 af = *(const LAS bf16x8*)(QS + (16 * I + r) * 136 + 32 * ks + 8 * q);
                const bf16x8 bf = *(const LAS bf16x8*)(KS + (8 * I * (I + 1) + 16 * J + r) * 136 + 32 * ks + 8 * q);
                acc = __builtin_amdgcn_mfma_f32_16x16x32_bf16(af, bf, acc, 0, 0, 0);
            }
        }
#pragma unroll
        for (int j = 0; j < 4; ++j) {
            float sv = acc[j]; if (J > I || (J == I && r > 4 * q + j)) sv = 0.f;
            PP[(16 * I + 4 * q + j) * 72 + 16 * J + r] = (bf16_t)f2bf(sv);
        }
    }
    __syncthreads();
    bf16x8 vf[2];
#pragma unroll
    for (int ks = 0; ks < 2; ++ks) vf[ks] = tr_frag(VS, 136, 32 * ks, 16 * w, r, q);
    f32x4 acc[4];
#pragma unroll
    for (int tt = 0; tt < 4; ++tt) {
        acc[tt] = (f32x4){0.f, 0.f, 0.f, 0.f};
#pragma unroll
        for (int ks = 0; ks < 2; ++ks) { const bf16x8 pf = *(const LAS bf16x8*)(PP + (16 * tt + r) * 72 + 32 * ks + 8 * q); acc[tt] = __builtin_amdgcn_mfma_f32_16x16x32_bf16(vf[ks], pf, acc[tt], 0, 0, 0); }
#pragma unroll
        for (int ks = 0; ks < 4; ++ks) { const bf16x8 qf = *(const LAS bf16x8*)(QE + (16 * tt + r) * 136 + 32 * ks + 8 * q); acc[tt] = __builtin_amdgcn_mfma_f32_16x16x32_bf16(sf[ks], qf, acc[tt], 0, 0, 0); }
        float s = (acc[tt][0] * acc[tt][0] + acc[tt][1] * acc[tt][1]) + (acc[tt][2] * acc[tt][2] + acc[tt][3] * acc[tt][3]);
        s += __shfl_xor(s, 16); s += __shfl_xor(s, 32);
        if (q == 0) RS[w * 64 + 16 * tt + r] = s;
    }
    __syncthreads();
    const f32x4 hgn = *(const f32x4*)(a->in[I_HGN] + l * 512 + G.h * 128 + 16 * w + 4 * q);
#pragma unroll
    for (int tt = 0; tt < 4; ++tt) {
        const int t = 16 * tt + r;
        float tot = 0.f;
#pragma unroll
        for (int ww = 0; ww < 8; ++ww) tot += RS[ww * 64 + t];
        const float rn = rsqrtf(tot * (1.f / 128.f) + EPS);
        if (t < G.L) {
            const size_t row = G.r0 + t;
            const u32x2 gt2 = graw[tt];
            const float g0 = bf2f((unsigned short)(gt2.x & 0xffffu)), g1 = bf2f((unsigned short)(gt2.x >> 16)), g2 = bf2f((unsigned short)(gt2.y & 0xffffu)), g3 = bf2f((unsigned short)(gt2.y >> 16));
            u32x2 wv; wv.x = cvt_pk_bf16(acc[tt][0] * rn * hgn[0] * g0, acc[tt][1] * rn * hgn[1] * g1); wv.y = cvt_pk_bf16(acc[tt][2] * rn * hgn[2] * g2, acc[tt][3] * rn * hgn[3] * g3);
            if (DBG_MASK & 1) wv = (u32x2){0u, 0u};
            *(u32x2*)(MIX + row * D + G.h * 128 + 16 * w + 4 * q) = wv;
        }
    }
    __syncthreads();
}

__device__ __forceinline__ void final_rows(ArgsP a, const bf16_t* XB, int m0, int m_end, int step, int lane) {
    const float* nf = a->in[I_NF]; float* outp = a->out;
    for (int m = m0; m < m_end; m += step) {
        float* o;
        if (m < MP) { const int b = m / TP, t = m - b * TP; if (t < NMETA) continue; o = outp + O_YP + ((size_t)b * SEQ + (t - NMETA)) * D; }
        else o = outp + O_YS + (size_t)(m - MP) * D;
        f32x4 x[4]; float s = 0.f;
#pragma unroll
        for (int j = 0; j < 4; ++j) { const u32x2 w = ((const u32x2*)(XB + (size_t)m * D))[lane + 64 * j];
            x[j] = (f32x4){__builtin_bit_cast(float, w.x << 16), __builtin_bit_cast(float, w.x & 0xffff0000u), __builtin_bit_cast(float, w.y << 16), __builtin_bit_cast(float, w.y & 0xffff0000u)};
            s += (x[j][0] * x[j][0] + x[j][1] * x[j][1]) + (x[j][2] * x[j][2] + x[j][3] * x[j][3]); }
        const float rstd = rsqrtf(wave_sum(s) * (1.f / D) + EPS);
#pragma unroll
        for (int j = 0; j < 4; ++j) { const f32x4 gn = ((const f32x4*)nf)[lane + 64 * j]; ((f32x4*)o)[lane + 64 * j] = x[j] * rstd * gn; }
    }
}

__global__ void __launch_bounds__(512, 2) mk_fwd(Args a_) {
    __shared__ __attribute__((aligned(16))) unsigned char lds_raw[LDS_BYTES];
    LAS unsigned char* lds = (LAS unsigned char*)lds_raw;
    const int ph_lo = a_.ph_lo, ph_hi = a_.ph_hi;
    volatile LAS unsigned* bst = (volatile LAS unsigned*)(lds + LDS_BYTES - 64);
    XcdBarrier bar; bar.bar = (unsigned*)(a_.ws + WS_CTL); bar.x = 0; bar.st = bst;
    if (ph_hi - ph_lo > 1) {
        if (threadIdx.x < 16) bst[threadIdx.x] = 0u;
        __syncthreads();
        bar = xcd_barrier_post((unsigned*)(a_.ws + WS_CTL), bst);
    }

    for (int ph = ph_lo; ph < ph_hi; ++ph) {
        ArgsP a = (ArgsP)__builtin_amdgcn_kernarg_segment_ptr();
        asm volatile("" : "+s"(a));
        int tid = threadIdx.x; asm volatile("" : "+v"(tid));
        const int lane = tid & 63, wave = __builtin_amdgcn_readfirstlane(tid >> 6);
        const int G = gridDim.x, bx = blockIdx.x;
        const int gw = bx * 8 + wave, NGW = G * 8;
        unsigned char* ws = a->ws;
        float* SS = (float*)(ws + WS_SS);
        float* LB = (float*)(ws + WS_LB);
        float* DEC = (float*)(ws + WS_DEC);
        float* X = (float*)(ws + WS_X);
        bf16_t* XB = (bf16_t*)(ws + WS_XB);
        bf16_t* MIX = (bf16_t*)(ws + WS_MIX);
        bf16_t* HB = (bf16_t*)(ws + WS_HZ);
        bf16_t* ZB = (bf16_t*)(ws + WS_HZ);
        float* GB = (float*)(ws + WS_HZ + (size_t)MPAD * INC * 2);
        bf16_t* CS = (bf16_t*)(ws + WS_CS);
        LAS float* scr = (LAS float*)(lds + wave * 8448);
        if (ph == 0) {
            for (int m = gw; m < MPAD; m += NGW) {
                const float* src = a->in[I_META];
                if (m < MP) { const int b = m / TP, t = m - b * TP; src = t < NMETA ? a->in[I_META] + (size_t)t * D : a->in[I_XP] + ((size_t)b * SEQ + (t - NMETA)) * D; }
                else if (m < MT) src = a->in[I_XS] + (size_t)(m - MP) * D;
                f32x4 v[4]; float s = 0.f;
#pragma unroll
                for (int j = 0; j < 4; ++j) v[j] = ((const f32x4*)src)[lane + 64 * j];
#pragma unroll
                for (int j = 0; j < 4; ++j) { if (m >= MT) v[j] = (f32x4){0.f, 0.f, 0.f, 0.f}; s += (v[j][0] * v[j][0] + v[j][1] * v[j][1]) + (v[j][2] * v[j][2] + v[j][3] * v[j][3]); }
                s = wave_sum(s);
#pragma unroll
                for (int j = 0; j < 4; ++j) {
                    u32x2 wv; wv.x = cvt_pk_bf16(v[j][0], v[j][1]); wv.y = cvt_pk_bf16(v[j][2], v[j][3]);
                    ((u32x2*)(XB + (size_t)m * D))[lane + 64 * j] = wv;
                    if (m >= MT) ((u32x2*)(MIX + (size_t)m * D))[lane + 64 * j] = (u32x2){0u, 0u};
                }
                if (lane < 16) SS[(size_t)m * 16 + lane] = lane == 0 ? s : 0.f;
            }
            {
                const int c = bx * 512 + tid;
                if (c < 512) {
                    float lg[4], mx = -1e30f;
#pragma unroll
                    for (int i = 0; i < 4; ++i) { lg[i] = a->in[I_LBL][i * 512 + c]; mx = fmaxf(mx, lg[i]); }
                    float sum = 0.f;
#pragma unroll
                    for (int i = 0; i < 4; ++i) { lg[i] = expf(lg[i] - mx); sum += lg[i]; }
                    const float inv = 1.f / sum; float cum = 0.f;
                    LB[c] = 0.f;
#pragma unroll
                    for (int i = 1; i < 4; ++i) { cum += lg[i] * inv; LB[i * 512 + c] = cum; }
                }
            }
            wconv_layer(a, 0, (bf16_t*)(ws + WS_W), scr, gw, NGW, lane);
            __syncthreads();
        } else {
            const int l = (ph - 1) / NK, k = KSEQ[(ph - 1) % NK];
            bf16_t* wset = (bf16_t*)(ws + WS_W + (size_t)(l & 1) * WSET_BYTES);
            bf16_t* wprev = (bf16_t*)(ws + WS_W + (size_t)((l + 1) & 1) * WSET_BYTES);
            bf16_t* HSv = (bf16_t*)(ws + WS_HS) - (size_t)MMAIN * FF;
            unsigned* cnts = (unsigned*)(ws + WS_CTL) + 4096;
            if (k == 3) {
                constexpr int NPI = NB * NCH * 2 + 16;
                constexpr int NIT = NHI + 512 + NPI; const int nrounds = (NIT + G - 1) / G;
                for (int k2 = 0; k2 < nrounds; ++k2) {
                    const int it = bx + ((k2 + bx) % nrounds) * G; if (it >= NIT) continue;
                    int t2 = tid; asm volatile("" : "+v"(t2));
                    if (it < NHI) hgrn_local_item(chunk_slot(it), ZB, GB, CS, DEC, lds, t2);
                    else if (it < NHI + 512) sample_item(it - NHI, l, a, ZB, GB, MIX, lds, t2);
                    else pool_item(it - NHI - 512, l, a, ZB, wset + WO_PW, MIX, lds, t2);
                }
            } else if (k == 4) {
                hgrn_scan(l, a, CS, (bf16_t*)(ws + WS_SB), DEC, bx * 512 + tid, G * 512);
                if (l + 1 < DEPTH) wconv_layer(a, l + 1, (bf16_t*)(ws + WS_W + (size_t)((l + 1) & 1) * WSET_BYTES), scr, gw, NGW, lane);
                __syncthreads();
            } else if (k == 5) {
                for (int it = bx; it < NHI; it += G) hgrn_out_item(chunk_slot(it), l, a, ZB, GB, (const bf16_t*)(ws + WS_SB), MIX, lds, tid);
            } else {
                const bool lastph = (ph == NPH - 1);
                const bool split = (k == 2) || lastph;
                const int nded = split ? 24 : NDED;
                {
                    const bool full = (k == 1 || k == 6 || k == 8);
                    const bool prod = !full && bx < (split ? 24 : NPROD) && !(k == 0 && l == 0);
                    if (full || prod) {
                        const int kk = full ? k : (k == 2 ? 1 : (k == 7 ? 6 : 8));
                        const bf16_t* wr_set = (k == 0) ? wprev : wset;
                        const int Kk = kk == 6 ? D : FF;
                        pg8::Gemm g = pg8::mk_gemm(full ? (kk == 6 ? MIX : HB) : (kk == 6 ? MIX : HSv), wr_set + (kk == 1 ? WO_1O : (kk == 8 ? WO_2O : WO_OUT)), MPAD, D, Kk);
                        pg8::Order S; int mode = 0; unsigned* pc = cnts + 64 * (12 + l * 12 + (bx >> 1));
                        if (full) S.init_static(MMAIN, D, G, bx);
                        else if (split) { S.init_list(4, bx >> 1, 0, 1); g.nt = Kk / 128; g.koff = (bx & 1) * (Kk / 2) * 2; mode = 1 + (bx & 1); }
                        else S.init_list(4, bx, 0, 1);
                        pg8::EpiResid E{X, XB, SS, kk == 6 ? 1.0f : 0.5f, mode, pc};
                        pg8::gemm_phase<pg8::EpiResid, pg8::Order, true, true>(lds, g, S, E, tid);
                        if (prod) handoff_publish(mode == 1 ? pc : cnts + 64 * ((k == 0 ? (l - 1) * 3 + 2 : l * 3 + (k == 2 ? 0 : 1))));
                    }
                }
                if (lastph) {
                    if (bx >= nded) {
                        final_rows(a, XB, (bx - nded) * 8 + wave, MMAIN, (G - nded) * 8, lane);
                        handoff_wait(cnts + 64 * 11, NPROD);
                        final_rows(a, XB, MMAIN + (bx - nded) * 8 + wave, MT, (G - nded) * 8, lane);
                    }
                } else if (k == 0 || k == 7) {
#pragma unroll 1
                    for (int pass = 0; pass < 2; ++pass) {
                        pg8::Gemm g = pg8::mk_gemm(XB, wset + (k == 0 ? WO_1I : WO_2I), MPAD, FF2, D); pg8::Order S; pg8::EpiSwiGLU E{pass ? HSv : HB, SS};
                        if (pass == 0) { if (bx < NDED) continue; S.init_static(MMAIN, FF2, G - NDED, bx - NDED); }
                        else {
                            if (k == 0 && l == 0) { if (bx < NDED) S.init_list(22, bx, NDED, bx < 2 ? 5 : 4); else break; }
                            else if (k == 0) { if (bx < NPROD) S.init_list(22, bx, NPROD, 3); else if (bx < NDED) S.init_list(22, 36 + (bx - NPROD), 4, 3); else if (bx >= G - 18) S.init_list(22, 48 + (bx - (G - 18)), 0, 1); else break; }
                            else { if (bx < NPROD) S.init_list(22, bx, NPROD, 4); else if (bx < NDED) S.init_list(22, 48 + (bx - NPROD), 4, bx - NPROD < 2 ? 5 : 4); else break; }
                            if (!(k == 0 && l == 0)) handoff_wait(cnts + 64 * (k == 0 ? (l - 1) * 3 + 2 : l * 3 + 1), NPROD);
                        }
                        pg8::gemm_phase<pg8::EpiSwiGLU, pg8::Order, true, true>(lds, g, S, E, tid);
                    }
                } else if (k == 2) {
#pragma unroll 1
                    for (int pass = 0; pass < 2; ++pass) {
                        pg8::Gemm g = pg8::mk_gemm(XB, wset + WO_IN, MPAD, INC, D); pg8::Order S; pg8::EpiMix E{ZB, GB, SS, LB + l * 512};
                        if (pass == 0) { if (bx < nded) continue; S.init_static(MMAIN, INC, G - nded, bx - nded); }
                        else {
                            if (bx < nded) S.init_list(10, bx, 0, 1); else if (bx >= G - 6) S.init_list(10, 24 + (bx - (G - 6)), 0, 1); else break;
                            handoff_wait(cnts + 64 * (l * 3 + 0), NPROD);
                        }
                        pg8::gemm_phase<pg8::EpiMix, pg8::Order, true, true>(lds, g, S, E, tid);
                    }
                }
            }
        }
        if (ph + 1 < ph_hi) {
            if (ph == ph_lo) cg::this_grid().sync();
            else xcd_barrier(bar);
        }
    }
}

extern "C" void kernel_launch(void* const* d_in, const int* in_sizes, int n_in, void* d_out, int out_size, void* d_ws, size_t ws_size, hipStream_t stream) {
    static int grid = 0;
    if (grid == 0) {
        if (n_in != 19 || ws_size < WS_END) { fprintf(stderr, "kernel_launch: unexpected inputs (n_in %d, ws %zu < %zu)\n", n_in, ws_size, (size_t)WS_END); grid = -1; return; }
        int dev = 0, cus = 0, per_cu = 0;
        (void)hipGetDevice(&dev);
        (void)hipDeviceGetAttribute(&cus, hipDeviceAttributeMultiprocessorCount, dev);
        (void)hipOccupancyMaxActiveBlocksPerMultiprocessor(&per_cu, (const void*)mk_fwd, 512, 0);
        if (per_cu < 1) per_cu = 1;
        (void)hipGetLastError();
        grid = cus * 1;
    }
    if (grid < 0) return;
    (void)hipMemsetAsync((char*)d_ws, 0, ZERO_BYTES, stream);
    Args a{};
    for (int i = 0; i < 19; ++i) a.in[i] = (const float*)d_in[i];
    a.out = (float*)d_out; a.ws = (unsigned char*)d_ws;
#if ONE_LAUNCH
    a.ph_lo = 0; a.ph_hi = NPH;
    void* args[] = {&a};
    hipError_t e = hipLaunchCooperativeKernel((const void*)mk_fwd, dim3(grid), dim3(512), args, 0, stream);
    if (e != hipSuccess) fprintf(stderr, "cooperative launch failed: %s (grid %d)\n", hipGetErrorString(e), grid);
#else
    for (int ph = 0; ph < NPH; ++ph) {
        if (ph >= DBG_NPH && ph != NPH - 1) continue;
        a.ph_lo = ph; a.ph_hi = ph + 1;
        hipLaunchKernelGGL(mk_fwd, dim3(grid), dim3(512), 0, stream, a);
    }
#endif
}
```

```cpp
#include <hip/hip_runtime.h>
#include <hip/hip_cooperative_groups.h>
#include <cstdio>
#include <cstdint>
namespace cg = cooperative_groups;

#ifndef ONE_LAUNCH
#define ONE_LAUNCH 1
#endif
#ifndef DBG_MASK
#define DBG_MASK 0
#endif
#ifndef DBG_NPH
#define DBG_NPH 37
#endif

#define LAS __attribute__((address_space(3)))
typedef unsigned short bf16_t;
typedef short bf16x8 __attribute__((ext_vector_type(8)));
typedef float f32x4 __attribute__((ext_vector_type(4)));
typedef unsigned u32x4 __attribute__((ext_vector_type(4)));
typedef unsigned u32x2 __attribute__((ext_vector_type(2)));

constexpr int D = 1024, NB = 8, SEQ = 2048, NMETA = 16, TP = SEQ + NMETA, DEPTH = 4, DBATCH = 128, DSEQ = 4;
constexpr int MP = NB * TP;
constexpr int MS = DBATCH * DSEQ;
constexpr int MT = MP + MS;
constexpr int MPAD = 17152;
constexpr int NH = 4, FF = 2816, FF2 = 5632, INC = 2560, PST = 15;
constexpr int NCH = 33;
constexpr int NHI = NB * NH * NCH;
constexpr float EPS = 1e-6f;

constexpr size_t O_YP = 0, O_YS = 16777216, O_HGP = 17301504, O_POOLP = 19398656, O_HGS = 19644416, O_POOLS = 53198848;

constexpr size_t WS_CTL = 0;
constexpr size_t WS_SS = 65536;
constexpr size_t SS_BYTES = (size_t)16 * MPAD * 4;
constexpr size_t ZERO_BYTES = 65536;
constexpr size_t WS_LB = 0x120000;
constexpr size_t WS_DEC = WS_LB + 65536;
constexpr size_t WS_W = 2u << 20;
constexpr size_t WSET_BYTES = 42074112;
constexpr size_t WS_X = WS_W + 2 * WSET_BYTES + 0;
constexpr size_t WS_XB = WS_X + (size_t)MPAD * D * 4;
constexpr size_t WS_MIX = WS_XB + (size_t)MPAD * D * 2;
constexpr size_t WS_HZ = WS_MIX + (size_t)MPAD * D * 2;
constexpr size_t HZ_BYTES = (size_t)MPAD * INC * 2 + (size_t)MPAD * 512 * 4;
constexpr size_t WS_CS = WS_HZ + HZ_BYTES;
constexpr size_t WS_SB = WS_CS + (size_t)NHI * 16384 * 4;
constexpr size_t WS_HS = WS_SB + (size_t)NHI * 16384 * 2;
constexpr size_t WS_END = WS_HS + (size_t)768 * FF * 2;
constexpr int MMAIN = 16384, NDED = 16, NPROD = 12;
constexpr size_t WO_1I = 0, WO_1O = 5767168, WO_IN = 8650752, WO_OUT = 11272192, WO_2I = 12320768, WO_2O = 18087936, WO_PW = 20971520;

constexpr int LDS_BYTES = 135168;
#ifndef DBG_REPM
#define DBG_REPM 0
#endif
#if DBG_REPM
constexpr int NK = 12;
__device__ const int KSEQ[NK] = {0, 1, 2, 3, 3, 4, 4, 5, 5, 6, 7, 8};
#else
constexpr int NK = 9;
__device__ const int KSEQ[NK] = {0, 1, 2, 3, 4, 5, 6, 7, 8};
#endif
constexpr int NPH = 2 + DEPTH * NK;

__device__ __forceinline__ unsigned f2bf(float f) { unsigned u = __builtin_bit_cast(unsigned, f); return (u + 0x7fffu + ((u >> 16) & 1u)) >> 16; }
__device__ __forceinline__ float bf2f(unsigned short h) { return __builtin_bit_cast(float, (unsigned)h << 16); }
typedef float f32x2_t __attribute__((ext_vector_type(2))); typedef __bf16 bf16x2_t __attribute__((ext_vector_type(2)));
__device__ __forceinline__ unsigned cvt_pk_bf16(float lo, float hi) { f32x2_t v = {lo, hi}; bf16x2_t b = __builtin_convertvector(v, bf16x2_t); return __builtin_bit_cast(unsigned, b); }
__device__ __forceinline__ float wave_sum(float v) {
#pragma unroll
    for (int o = 1; o < 64; o <<= 1) v += __shfl_xor(v, o);
    return v;
}
__device__ __forceinline__ float row_rstd(const float* ssp, int row) {
    const f32x4* p = (const f32x4*)(ssp + (size_t)row * 16); const f32x4 a = p[0], b = p[1], c = p[2], d = p[3];
    const float s = (((a[0] + a[1]) + (a[2] + a[3])) + ((b[0] + b[1]) + (b[2] + b[3]))) + (((c[0] + c[1]) + (c[2] + c[3])) + ((d[0] + d[1]) + (d[2] + d[3])));
    return rsqrtf(s * (1.f / D) + EPS);
}
__device__ __forceinline__ float silu_f(float x) { return x * __builtin_amdgcn_rcpf(1.f + __expf(-x)); }
__device__ __forceinline__ f32x4 swiglu4(f32x4 g, f32x4 u) {
    const f32x4 gc = __builtin_elementwise_max(g, (f32x4){-40.f, -40.f, -40.f, -40.f});
    const f32x4 t = gc * (-1.4426950408889634f);
    f32x4 a; a[0] = __builtin_amdgcn_exp2f(t[0]); a[1] = __builtin_amdgcn_exp2f(t[1]); a[2] = __builtin_amdgcn_exp2f(t[2]); a[3] = __builtin_amdgcn_exp2f(t[3]);
    a = a + 1.0f;
    const float r01 = __builtin_amdgcn_rcpf(a[0] * a[1]), r23 = __builtin_amdgcn_rcpf(a[2] * a[3]);
    const f32x4 inv = (f32x4){a[1] * r01, a[0] * r01, a[3] * r23, a[2] * r23};
    return (gc * u) * inv;
}

namespace pg8 {
constexpr int BM = 256, BK = 64, HALF = 128, HTB = HALF * BK * 2, STAGE_BYTES = 8 * HTB, NXCD = 8, WGM = 8;
__host__ __device__ __forceinline__ int lds_byte(int r, int c) { const int st = (r >> 4) * 2 + (c >> 5), rr = r & 15, cc = c & 31, ob = rr * 64 + cc * 2; return st * 1024 + (ob ^ (((ob >> 9) & 1) << 5)); }
__host__ __device__ __forceinline__ void stage_rc(int b, int& R, int& C) { const int st = b / 1024, sb = b % 1024, swz = sb ^ (((sb >> 9) & 1) << 5); R = (st >> 1) * 16 + swz / 64; C = (st & 1) * 32 + (swz % 64) / 2; }
__host__ __device__ __forceinline__ int perm32(int rho) { const int n = rho >> 4, i = rho & 15; return 8 * (i >> 2) + 4 * n + (i & 3); }

struct Unit { int pm, pn; };
struct Gemm { const bf16_t* A; const bf16_t* Bt; int M, N, K, nt, koff; };
__device__ __forceinline__ Gemm mk_gemm(const bf16_t* A, const bf16_t* Bt, int M, int N, int K) { Gemm g; g.A = A; g.Bt = Bt; g.M = M; g.N = N; g.K = K; g.nt = K / 64; g.koff = 0; return g; }

struct StaticOrder {
    int nM, nN, nwg, G, c;
    __host__ __device__ void init(int M, int N, int G_, int c_) { nM = M / BM; nN = N / BM; nwg = nM * nN; G = G_; c = c_; }
    __host__ __device__ bool next(int i, Unit& u) const {
        const long L = (long)i * G + c; if (L >= nwg) return false;
        int wgid = (int)L; { const int q = nwg / NXCD, r = nwg % NXCD, xcd = wgid % NXCD, off = wgid / NXCD; wgid = (xcd < r ? xcd * (q + 1) : r * (q + 1) + (xcd - r) * q) + off; }
        const int nig = WGM * nN, gid = wgid / nig, fm = gid * WGM, gsz = (nM - fm) < WGM ? (nM - fm) : WGM;
        u.pm = fm + ((wgid % nig) % gsz); u.pn = (wgid % nig) / gsz; return true;
    }
    __device__ __forceinline__ void a_ready(const Unit&) const {}
    __device__ __forceinline__ void done(const Unit&) const {}
};

struct Order {
    StaticOrder so; int mode, nN, first, step, n;
    __device__ void init_static(int M, int N, int G_, int c_) { mode = 0; so.init(M, N, G_, c_); nN = 0; first = 0; step = 0; n = 0; }
    __device__ void init_list(int nN_, int first_, int step_, int n_) { mode = 1; so.init(256, 256, 1, 0); nN = nN_; first = first_; step = step_; n = n_; }
    __device__ bool next(int i, Unit& u) const {
        if (mode == 0) return so.next(i, u);
        if (i >= n) return false; const int L = first + i * step; u.pm = 64 + L / nN; u.pn = L - (L / nN) * nN; return true;
    }
    __device__ __forceinline__ void a_ready(const Unit&) const {}
    __device__ __forceinline__ void done(const Unit&) const {}
};


struct EpiSwiGLU {
    static constexpr bool PERM = true, AFTER_DRAIN = false;
    bf16_t* H; const float* ss;
    __device__ __forceinline__ void operator()(const f32x4 (&acc)[2][2][4][2], const Unit& u, int wr, int wc, int fr, int fq) const {
        const int row0 = u.pm * BM + wr * 64 + fr; const int col0 = u.pn * HALF + wc * 32 + 8 * fq;
#pragma unroll
        for (int ai = 0; ai < 2; ++ai)
#pragma unroll
            for (int m = 0; m < 4; ++m) {
                const int row = row0 + ai * HALF + m * 16;
                const float rstd = row_rstd(ss, row);
                const f32x4 g0 = acc[ai][0][m][0] * rstd, g1 = acc[ai][0][m][1] * rstd, u0 = acc[ai][1][m][0] * rstd, u1 = acc[ai][1][m][1] * rstd;
                u32x4 w;
                const f32x4 h0 = swiglu4(g0, u0), h1 = swiglu4(g1, u1);
                w.x = cvt_pk_bf16(h0[0], h0[1]); w.y = cvt_pk_bf16(h0[2], h0[3]);
                w.z = cvt_pk_bf16(h1[0], h1[1]); w.w = cvt_pk_bf16(h1[2], h1[3]);
                *(u32x4*)(H + (size_t)row * FF + col0) = w;
            }
    }
};

struct EpiResid {
    static constexpr bool PERM = false, AFTER_DRAIN = false;
    float* XS; bf16_t* XB; float* ssn; float c; int mode; unsigned* pcnt;
    static __device__ __forceinline__ float store_round(bf16_t* p, const f32x4 x) {
        u32x2 w; w.x = cvt_pk_bf16(x[0], x[1]); w.y = cvt_pk_bf16(x[2], x[3]);
        *(u32x2*)p = w;
        const f32x4 sq = x * x;
        return (sq[0] + sq[1]) + (sq[2] + sq[3]);
    }
    __device__ __forceinline__ void operator()(const f32x4 (&acc)[2][2][4][2], const Unit& u, int wr, int wc, int fr, int fq) const {
        const int row0 = u.pm * BM + wr * 64 + fr; const int col0 = u.pn * BM + wc * 32 + 4 * fq;
        float* xs = XS + (size_t)(u.pn + 4 * (u.pm - 64)) * 65536 + (wr * 64 + fr) * 256 + wc * 32 + 4 * fq;
        if (mode == 2) { unsigned sp = 0; while (__hip_atomic_load(pcnt, __ATOMIC_RELAXED, __HIP_MEMORY_SCOPE_AGENT) < 1u) { __builtin_amdgcn_s_sleep(2); if (++sp > (1u << 24)) break; }
            __builtin_amdgcn_fence(__ATOMIC_ACQUIRE, "agent"); asm volatile("s_waitcnt vmcnt(0)" ::: "memory"); }
        if (mode == 2) {
#pragma unroll
            for (int aim = 0; aim < 4; ++aim) { const int ai = aim >> 1, m0 = (aim & 1) * 2;
                f32x4 xv[2][2][2];
#pragma unroll
                for (int mm = 0; mm < 2; ++mm)
#pragma unroll
                    for (int bj = 0; bj < 2; ++bj)
#pragma unroll
                        for (int n = 0; n < 2; ++n) xv[mm][bj][n] = *(const f32x4*)(xs + (ai * HALF + (m0 + mm) * 16) * 256 + bj * HALF + n * 16);
#pragma unroll
                for (int mm = 0; mm < 2; ++mm) { const int m = m0 + mm; const int row = row0 + ai * HALF + m * 16; bf16_t* xb = XB + (size_t)row * D + col0; float q = 0.f;
#pragma unroll
                    for (int bj = 0; bj < 2; ++bj)
#pragma unroll
                        for (int n = 0; n < 2; ++n) { const f32x4 x = xv[mm][bj][n] + acc[ai][bj][m][n] * c; q += store_round(xb + bj * HALF + n * 16, x); }
                    q += __shfl_xor(q, 16); q += __shfl_xor(q, 32);
                    if (fq == 0) ssn[(size_t)row * 16 + u.pn * 4 + wc] = q; }
                asm volatile("" ::: "memory");
            }
        } else {
            u32x2 raw[2][4][2][2];
#pragma unroll
            for (int ai = 0; ai < 2; ++ai)
#pragma unroll
                for (int m = 0; m < 4; ++m) { const char* xb = (const char*)XB + (unsigned)(((row0 + ai * HALF + m * 16) * D + col0) * 2);
#pragma unroll
                    for (int bj = 0; bj < 2; ++bj)
#pragma unroll
                        for (int n = 0; n < 2; ++n) raw[ai][m][bj][n] = *(const u32x2*)(xb + (bj * HALF + n * 16) * 2); }
#pragma unroll
            for (int ai = 0; ai < 2; ++ai) {
#pragma unroll
                for (int m = 0; m < 4; ++m) { const int row = row0 + ai * HALF + m * 16; bf16_t* xb = (bf16_t*)((char*)XB + (unsigned)((row * D + col0) * 2)); float q = 0.f;
#pragma unroll
                    for (int bj = 0; bj < 2; ++bj)
#pragma unroll
                        for (int n = 0; n < 2; ++n) { const u32x2 w = raw[ai][m][bj][n];
                            const f32x4 xo = (f32x4){__builtin_bit_cast(float, w.x << 16), __builtin_bit_cast(float, w.x & 0xffff0000u), __builtin_bit_cast(float, w.y << 16), __builtin_bit_cast(float, w.y & 0xffff0000u)};
                            const f32x4 x = xo + acc[ai][bj][m][n] * c;
                            if (mode == 1) *(f32x4*)(xs + (ai * HALF + m * 16) * 256 + bj * HALF + n * 16) = x;
                            else q += store_round(xb + bj * HALF + n * 16, x); }
                    q += __shfl_xor(q, 16); q += __shfl_xor(q, 32);
                    if (fq == 0 && mode != 1) ssn[(size_t)row * 16 + u.pn * 4 + wc] = q; }
                asm volatile("" ::: "memory");
            }
        }
    }
};

struct EpiMix {
    static constexpr bool PERM = true, AFTER_DRAIN = false;
    bf16_t* ZB; float* GB; const float* ss; const float* lb;
    __device__ __forceinline__ void operator()(const f32x4 (&acc)[2][2][4][2], const Unit& u, int wr, int wc, int fr, int fq) const {
        const int row0 = u.pm * BM + wr * 64 + fr; const int seg = u.pn >> 1; const int cs0 = (u.pn & 1) * BM + wc * 32 + 8 * fq;
        if (seg == 1) {
#pragma unroll
            for (int bj = 0; bj < 2; ++bj) {
                const int cs = cs0 + bj * HALF;
                const f32x4 l0 = *(const f32x4*)(lb + cs), l1 = *(const f32x4*)(lb + cs + 4);
#pragma unroll
                for (int ai = 0; ai < 2; ++ai)
#pragma unroll
                    for (int m = 0; m < 4; ++m) {
                        const int row = row0 + ai * HALF + m * 16;
                        const float rstd = row_rstd(ss, row);
                        float kk[8], gg[8];
#pragma unroll
                        for (int e = 0; e < 8; ++e) {
                            const float z = (e < 4 ? acc[ai][bj][m][0][e & 3] : acc[ai][bj][m][1][e & 3]) * rstd;
                            const float lbv = e < 4 ? l0[e & 3] : l1[e & 3];
                            const float e2 = __expf(-fabsf(z)); const float r = __builtin_amdgcn_rcpf(1.f + e2);
                            const float sp = z >= 0.f ? r : e2 * r;
                            const float sm = z >= 0.f ? e2 * r : r;
                            kk[e] = (1.f - lbv) * sm;
                            gg[e] = __logf(lbv + (1.f - lbv) * sp);
                        }
                        u32x4 w; w.x = cvt_pk_bf16(kk[0], kk[1]); w.y = cvt_pk_bf16(kk[2], kk[3]); w.z = cvt_pk_bf16(kk[4], kk[5]); w.w = cvt_pk_bf16(kk[6], kk[7]);
                        *(u32x4*)(ZB + (size_t)row * INC + 512 + cs) = w;
                        *(f32x4*)(GB + (size_t)row * 512 + cs) = (f32x4){gg[0], gg[1], gg[2], gg[3]};
                        *(f32x4*)(GB + (size_t)row * 512 + cs + 4) = (f32x4){gg[4], gg[5], gg[6], gg[7]};
                    }
            }
        } else {
            const bool act = (seg == 0) || (seg == 3);
#pragma unroll
            for (int ai = 0; ai < 2; ++ai)
#pragma unroll
                for (int m = 0; m < 4; ++m) {
                    const int row = row0 + ai * HALF + m * 16;
                    const float rstd = row_rstd(ss, row);
#pragma unroll
                    for (int bj = 0; bj < 2; ++bj) {
                        f32x4 z0 = acc[ai][bj][m][0] * rstd, z1 = acc[ai][bj][m][1] * rstd;
                        if (act) {
#pragma unroll
                            for (int e = 0; e < 4; ++e) { z0[e] = silu_f(z0[e]); z1[e] = silu_f(z1[e]); }
                        }
                        u32x4 w; w.x = cvt_pk_bf16(z0[0], z0[1]); w.y = cvt_pk_bf16(z0[2], z0[3]); w.z = cvt_pk_bf16(z1[0], z1[1]); w.w = cvt_pk_bf16(z1[2], z1[3]);
                        *(u32x4*)(ZB + (size_t)row * INC + seg * 512 + cs0 + bj * HALF) = w;
                    }
                }
        }
    }
};

template <class Epi, class Sched, bool ALIGN_EPI = false, bool SP2 = false>
__device__ __forceinline__ void gemm_phase(LAS unsigned char* lds, const Gemm g, const Sched& S, const Epi& E, const int tid) {
    const int wid = __builtin_amdgcn_readfirstlane(tid >> 6), lane = tid & 63, wr = wid >> 2, wc = wid & 3, fr = lane & 15, fq = lane >> 4;
    const int K = g.K, nt = g.nt;
    unsigned voffA[2], voffB[2];
#pragma unroll
    for (int i = 0; i < 2; ++i) { int R, C; stage_rc(tid * 16 + i * 8192, R, C); const int Rb = Epi::PERM ? ((R & ~31) + perm32(R & 31)) : R;
        voffA[i] = (unsigned)(R * K + C) * 2u; voffB[i] = (unsigned)(Rb * K + C) * 2u; }
    const size_t kstep = (size_t)(BK * 2);
    const size_t hstep = (size_t)HALF * K * 2;
    const size_t tstep = 2 * hstep;
    const unsigned ldsw = (unsigned)wid * 1024u;
    const int aoff = lds_byte(wr * 64 + fr, fq * 8), boff = lds_byte(wc * 32 + fr, fq * 8);
#define PG8_SA(b, h) (((b) * 2 + (h)) * HTB)
#define PG8_SB(b, h) ((4 + (b) * 2 + (h)) * HTB)
#define PG8_STAGE(bufoff, gbase, voff) do { _Pragma("unroll") for (int _i = 0; _i < 2; ++_i) \
        __builtin_amdgcn_global_load_lds((const unsigned*)((const char*)(gbase) + (voff)[_i]), (LAS unsigned*)(lds + (bufoff) + ldsw + _i * 8192), 16, 0, 0); } while (0)
#define PG8_LDA(dst, b, h) do { _Pragma("unroll") for (int m = 0; m < 4; ++m) _Pragma("unroll") for (int k = 0; k < 2; ++k) dst[m][k] = *(const LAS bf16x8*)(lds + PG8_SA(b, h) + aoff + m * 2048 + k * 1024); } while (0)
#define PG8_LDB(dst, b, h) do { _Pragma("unroll") for (int n = 0; n < 2; ++n) _Pragma("unroll") for (int k = 0; k < 2; ++k) dst[n][k] = *(const LAS bf16x8*)(lds + PG8_SB(b, h) + boff + n * 2048 + k * 1024); } while (0)
#define PG8_MMA(ai, bj, At, Bt) do { __builtin_amdgcn_s_setprio(1); _Pragma("unroll") for (int m = 0; m < 4; ++m) _Pragma("unroll") for (int n = 0; n < 2; ++n) _Pragma("unroll") for (int k = 0; k < 2; ++k) \
        acc[ai][bj][m][n] = __builtin_amdgcn_mfma_f32_16x16x32_bf16(Bt[n][k], At[m][k], acc[ai][bj][m][n], 0, 0, 0); __builtin_amdgcn_s_setprio(0); } while (0)
#define PG8_WAIT_V(n) asm volatile("s_waitcnt vmcnt(" #n ")" ::: "memory")
#define PG8_WAIT_L(n) asm volatile("s_waitcnt lgkmcnt(" #n ")" ::: "memory")
#define PG8_BAR __builtin_amdgcn_s_barrier()
#define PG8_SCHED __builtin_amdgcn_sched_barrier(0)
    Unit cur, nxt; int ui = 0;
    if (!S.next(0, cur)) return;
    f32x4 acc[2][2][4][2];
#pragma unroll
    for (int a = 0; a < 2; ++a)
#pragma unroll
        for (int b = 0; b < 2; ++b)
#pragma unroll
            for (int m = 0; m < 4; ++m)
#pragma unroll
                for (int n = 0; n < 2; ++n) acc[a][b][m][n] = (f32x4){0.f, 0.f, 0.f, 0.f};
    bf16x8 At[4][2], B0[2][2], B1[2][2];
    const char* gA = (const char*)g.A + g.koff; const char* gB = (const char*)g.Bt + g.koff;
    const char* cA = gA + (size_t)cur.pm * tstep; const char* cB = gB + (size_t)cur.pn * tstep;
    S.a_ready(cur);
    if constexpr (SP2) {
        PG8_STAGE(PG8_SB(0, 0), cB, voffB); PG8_STAGE(PG8_SB(0, 1), cB + hstep, voffB); PG8_STAGE(PG8_SA(0, 0), cA, voffA); PG8_STAGE(PG8_SA(0, 1), cA + hstep, voffA);
        if (wr == 1) PG8_BAR;
        PG8_WAIT_V(2); PG8_BAR;
        PG8_STAGE(PG8_SB(1, 0), cB + kstep, voffB); PG8_STAGE(PG8_SA(1, 0), cA + kstep, voffA); PG8_STAGE(PG8_SB(1, 1), cB + hstep + kstep, voffB);
        PG8_WAIT_V(6); PG8_BAR;
    } else {
        PG8_STAGE(PG8_SB(0, 0), cB, voffB); PG8_STAGE(PG8_SA(0, 0), cA, voffA); PG8_STAGE(PG8_SB(0, 1), cB + hstep, voffB); PG8_STAGE(PG8_SA(0, 1), cA + hstep, voffA);
        if (wr == 1) PG8_BAR;
        PG8_WAIT_V(4); PG8_BAR;
        PG8_STAGE(PG8_SB(1, 0), cB + kstep, voffB); PG8_STAGE(PG8_SA(1, 0), cA + kstep, voffA); PG8_STAGE(PG8_SB(1, 1), cB + hstep + kstep, voffB);
        PG8_WAIT_V(6); PG8_BAR;
    }
    for (;;) {
        const bool has_next = S.next(ui + 1, nxt);
        const char* nA = has_next ? gA + (size_t)nxt.pm * tstep : cA; const char* nB = has_next ? gB + (size_t)nxt.pn * tstep : cB;
        for (int t = 0; t < nt; t += 2) {
            const bool last = (t == nt - 2);
            const char* a1 = cA + (size_t)(t + 1) * kstep;
            const char* a2 = last ? nA : cA + (size_t)(t + 2) * kstep; const char* b2 = last ? nB : cB + (size_t)(t + 2) * kstep;
            const char* a3 = a2 + kstep; const char* b3 = b2 + kstep;
            if (last && has_next) S.a_ready(nxt);
            if constexpr (SP2) {
            PG8_LDB(B0, 0, 0); PG8_LDB(B1, 0, 1); PG8_SCHED; PG8_LDA(At, 0, 0); PG8_STAGE(PG8_SA(1, 1), a1 + hstep, voffA);
            PG8_WAIT_V(8); PG8_WAIT_L(0); PG8_BAR; PG8_MMA(0, 0, At, B0); PG8_MMA(0, 1, At, B1); PG8_BAR; PG8_SCHED;
            PG8_LDA(At, 0, 1); PG8_STAGE(PG8_SB(0, 0), b2, voffB); PG8_STAGE(PG8_SB(0, 1), b2 + hstep, voffB); PG8_STAGE(PG8_SA(0, 0), a2, voffA);
            PG8_WAIT_V(8); PG8_WAIT_L(0); PG8_BAR; PG8_MMA(1, 0, At, B0); PG8_MMA(1, 1, At, B1); PG8_BAR; PG8_SCHED;
            PG8_LDB(B0, 1, 0); PG8_LDB(B1, 1, 1); PG8_SCHED; PG8_LDA(At, 1, 0); PG8_STAGE(PG8_SA(0, 1), a2 + hstep, voffA);
            PG8_WAIT_V(8); PG8_WAIT_L(0); PG8_BAR; PG8_MMA(0, 0, At, B0); PG8_MMA(0, 1, At, B1); PG8_BAR; PG8_SCHED;
            PG8_LDA(At, 1, 1); PG8_STAGE(PG8_SB(1, 0), b3, voffB); PG8_STAGE(PG8_SB(1, 1), b3 + hstep, voffB); PG8_STAGE(PG8_SA(1, 0), a3, voffA);
            PG8_WAIT_V(8); PG8_WAIT_L(0); PG8_BAR; PG8_MMA(1, 0, At, B0); PG8_MMA(1, 1, At, B1); PG8_BAR; PG8_SCHED;
            } else {
            PG8_LDB(B0, 0, 0); PG8_SCHED; PG8_LDA(At, 0, 0); PG8_STAGE(PG8_SA(1, 1), a1 + hstep, voffA);
            PG8_WAIT_L(8); PG8_BAR; PG8_WAIT_L(0); PG8_MMA(0, 0, At, B0); PG8_BAR; PG8_SCHED;
            PG8_LDB(B1, 0, 1); PG8_STAGE(PG8_SB(0, 0), b2, voffB);
            PG8_BAR; PG8_WAIT_L(0); PG8_MMA(0, 1, At, B1); PG8_BAR;
            PG8_LDA(At, 0, 1); PG8_STAGE(PG8_SA(0, 0), a2, voffA);
            PG8_BAR; PG8_WAIT_L(0); PG8_MMA(1, 0, At, B0); PG8_BAR; PG8_SCHED;
            PG8_STAGE(PG8_SB(0, 1), b2 + hstep, voffB);
            PG8_WAIT_V(6); PG8_BAR; PG8_MMA(1, 1, At, B1); PG8_BAR;
            PG8_LDB(B0, 1, 0); PG8_SCHED; PG8_LDA(At, 1, 0); PG8_STAGE(PG8_SA(0, 1), a2 + hstep, voffA);
            PG8_WAIT_L(8); PG8_BAR; PG8_WAIT_L(0); PG8_MMA(0, 0, At, B0); PG8_BAR; PG8_SCHED;
            PG8_LDB(B1, 1, 1); PG8_STAGE(PG8_SB(1, 0), b3, voffB);
            PG8_BAR; PG8_WAIT_L(0); PG8_MMA(0, 1, At, B1); PG8_BAR;
            PG8_LDA(At, 1, 1); PG8_STAGE(PG8_SA(1, 0), a3, voffA);
            PG8_BAR; PG8_WAIT_L(0); PG8_MMA(1, 0, At, B0); PG8_BAR; PG8_SCHED;
            PG8_STAGE(PG8_SB(1, 1), b3 + hstep, voffB);
            PG8_WAIT_V(6); PG8_BAR; PG8_MMA(1, 1, At, B1); PG8_BAR;
            }
        }
        if constexpr (ALIGN_EPI) { if (wr == 0) PG8_BAR; }
        if constexpr (!Epi::AFTER_DRAIN) { E(acc, cur, wr, wc, fr, fq); S.done(cur); }
        if (!has_next) break;
#pragma unroll
        for (int a = 0; a < 2; ++a)
#pragma unroll
            for (int b = 0; b < 2; ++b)
#pragma unroll
                for (int m = 0; m < 4; ++m)
#pragma unroll
                    for (int n = 0; n < 2; ++n) acc[a][b][m][n] = (f32x4){0.f, 0.f, 0.f, 0.f};
        cur = nxt; cA = nA; cB = nB; ++ui;
        if constexpr (ALIGN_EPI) { if (wr == 1) PG8_BAR; }
    }
    PG8_WAIT_V(0);
    if constexpr (!ALIGN_EPI) { if (wr == 0) PG8_BAR; }
    PG8_BAR;
#undef PG8_SA
#undef PG8_SB
#undef PG8_STAGE
#undef PG8_LDA
#undef PG8_LDB
#undef PG8_MMA
#undef PG8_WAIT_V
#undef PG8_WAIT_L
#undef PG8_BAR
#undef PG8_SCHED
}
}

#define XB_TMO      128
#define XB_XCNT(j)  (256  + 64 * (j))
#define XB_XSUB(j)  (1280 + 64 * (j))
#define XB_XGEN(j)  (2304 + 64 * (j))
#define XB_TOP      3328
#define XB_TOPGEN   3392
#define XCD_BAR_WORDS 3456
#define XB_SPIN_CAP (1u << 22)
__device__ __forceinline__ unsigned xb_ld(unsigned* p)              { return __hip_atomic_load(p, __ATOMIC_RELAXED, __HIP_MEMORY_SCOPE_AGENT); }
__device__ __forceinline__ unsigned xb_add(unsigned* p, unsigned v) { return __hip_atomic_fetch_add(p, v, __ATOMIC_RELAXED, __HIP_MEMORY_SCOPE_AGENT); }
__device__ __forceinline__ unsigned xb_xcc_id() { return (unsigned)__builtin_amdgcn_s_getreg((3 << 11) | 20) & 0xFu; }
#define XB_SPIN(cond, bar) do { unsigned _sp = 0; while (cond) { __builtin_amdgcn_s_sleep(1); \
    if ((++_sp & 255u) == 0u) { if (xb_ld(&(bar)[XB_TMO])) break; if (_sp > XB_SPIN_CAP) { atomicAdd(&(bar)[XB_TMO], 1u); break; } } } } while (0)
struct XcdBarrier { unsigned* bar; unsigned x; volatile LAS unsigned* st; };
__device__ __forceinline__ XcdBarrier xcd_barrier_post(unsigned* bar, volatile LAS unsigned* st) {
    XcdBarrier b; b.bar = bar; b.x = xb_xcc_id(); b.st = st;
    if (threadIdx.x == 0) (void)xb_add(&bar[XB_XCNT(b.x)], 1u);
    return b;
}
__device__ __forceinline__ void xcd_barrier_complete(unsigned* bar, unsigned x, unsigned& nloc, unsigned& nx) {
    const unsigned G = gridDim.x * gridDim.y * gridDim.z;
    unsigned sum, cnt, mine, sp = 0u;
    for (;;) {
        sum = 0u; cnt = 0u; mine = 0u;
#pragma unroll
        for (unsigned j = 0; j < 16; ++j) { const unsigned c = xb_ld(&bar[XB_XCNT(j)]); sum += c; cnt += (c > 0u) ? 1u : 0u; mine = (j == x) ? c : mine; }
        if (sum == G) break;
        __builtin_amdgcn_s_sleep(1);
        if ((++sp & 255u) == 0u) { if (xb_ld(&bar[XB_TMO])) break; if (sp > XB_SPIN_CAP) { atomicAdd(&bar[XB_TMO], 1u); break; } }
    }
    nloc = mine > 0u ? mine : 1u; nx = cnt > 0u ? cnt : 1u;
}
__device__ __forceinline__ void xcd_barrier(const XcdBarrier& b) {
    asm volatile("s_waitcnt vmcnt(0)" ::: "memory");
    __syncthreads();
    if (threadIdx.x == 0) {
        unsigned* bar = b.bar;
        __builtin_amdgcn_s_waitcnt(0);
        unsigned nloc = b.st[0], nx = b.st[1];
        if (nloc == 0u) { xcd_barrier_complete(bar, b.x, nloc, nx); b.st[0] = nloc; b.st[1] = nx; }
        const unsigned old = xb_add(&bar[XB_XSUB(b.x)], 1u);
        const unsigned gen = old / nloc;
        if (old + 1u == (gen + 1u) * nloc) {
            __builtin_amdgcn_fence(__ATOMIC_RELEASE, "agent");
            asm volatile("s_waitcnt vmcnt(0)" ::: "memory");
            const unsigned og = xb_add(&bar[XB_TOP], 1u);
            const unsigned tg = og / nx;
            if (og + 1u == (tg + 1u) * nx) xb_add(&bar[XB_TOPGEN], 1u);
            else XB_SPIN(xb_ld(&bar[XB_TOPGEN]) == tg, bar);
            __builtin_amdgcn_fence(__ATOMIC_ACQUIRE, "agent");
            xb_add(&bar[XB_XGEN(b.x)], 1u);
            asm volatile("s_waitcnt vmcnt(0)" ::: "memory");
        } else {
            XB_SPIN(xb_ld(&bar[XB_XGEN(b.x)]) == gen, bar);
            __builtin_amdgcn_fence(__ATOMIC_ACQUIRE, "agent");
            asm volatile("s_waitcnt vmcnt(0)" ::: "memory");
        }
    }
    __syncthreads();
}

__device__ __forceinline__ void handoff_publish(unsigned* cnt) {
    asm volatile("s_waitcnt vmcnt(0)" ::: "memory");
    __syncthreads();
    if (threadIdx.x == 0) {
        __builtin_amdgcn_fence(__ATOMIC_RELEASE, "agent");
        asm volatile("s_waitcnt vmcnt(0)" ::: "memory");
        (void)xb_add(cnt, 1u);
    }
}
__device__ __forceinline__ void handoff_wait(unsigned* cnt, unsigned target) {
    unsigned sp = 0;
    while (xb_ld(cnt) < target) { __builtin_amdgcn_s_sleep(4); if (++sp > (1u << 24)) break; }
    __builtin_amdgcn_fence(__ATOMIC_ACQUIRE, "agent");
    asm volatile("s_waitcnt vmcnt(0)" ::: "memory");
}

struct Args { const float* in[19]; float* out; unsigned char* ws; int ph_lo, ph_hi; };
typedef const __attribute__((address_space(4))) Args* ArgsP;
enum { I_XP = 0, I_XS, I_SHG, I_SPOOL, I_META, I_LBL, I_N1, I_W1I, I_W1O, I_NM, I_WIN, I_HGN, I_PW, I_PS, I_WOUT, I_N2, I_W2I, I_W2O, I_NF };

__device__ __forceinline__ void conv_item(const float* W, int ldw, const float* kscale, const float* nscale, bf16_t* WT, int ldt, int drow0, int k0, int n0, LAS float* scr, int lane) {
    float wv[32];
#pragma unroll
    for (int i = 0; i < 32; ++i) wv[i] = W[(size_t)(k0 + 2 * i + (lane >> 5)) * ldw + n0 + (lane & 31)];
    const float ns = nscale ? nscale[n0 + (lane & 31)] : 1.f;
    float ksv[2];
    ksv[0] = kscale ? kscale[k0 + lane] : 1.f;
#pragma unroll
    for (int i = 0; i < 32; ++i) {
        const int kk = 2 * i + (lane >> 5), n = lane & 31;
        const float kv = __builtin_bit_cast(float, __builtin_amdgcn_ds_bpermute(kk << 2, __builtin_bit_cast(int, ksv[0])));
        scr[kk * 33 + n] = wv[i] * kv * ns;
    }
    asm volatile("s_waitcnt lgkmcnt(0)" ::: "memory");
    const int c = lane & 7;
#pragma unroll
    for (int j = 0; j < 4; ++j) {
        const int n = (lane >> 3) + 8 * j; const LAS float* s = scr + (8 * c) * 33 + n;
        u32x4 o; o.x = cvt_pk_bf16(s[0 * 33], s[1 * 33]); o.y = cvt_pk_bf16(s[2 * 33], s[3 * 33]); o.z = cvt_pk_bf16(s[4 * 33], s[5 * 33]); o.w = cvt_pk_bf16(s[6 * 33], s[7 * 33]);
        *(u32x4*)(WT + (size_t)(drow0 + n) * ldt + k0 + 8 * c) = o;
    }
    asm volatile("s_waitcnt lgkmcnt(0)" ::: "memory");
}

__device__ __forceinline__ void wconv_layer(ArgsP a, int l, bf16_t* ws_set, LAS float* scr, int gw, int NGW, int lane) {
    constexpr int I1 = 16 * 176, I2 = 44 * 32, I3 = 16 * 80, I4 = 16 * 32, I7 = 32;
    for (int it = gw; it < 2 * I1 + 2 * I2 + I3 + I4 + I7; it += NGW) {
        int r = it; const float* W; const float* ks = nullptr; const float* ns = nullptr; bf16_t* WT; int K, N; int mode = 0;
        if (r < I1) { W = a->in[I_W1I] + (size_t)l * D * FF2; ks = a->in[I_N1] + l * D; WT = ws_set + WO_1I; K = D; N = FF2; mode = 1; }
        else if ((r -= I1) < I2) { W = a->in[I_W1O] + (size_t)l * FF * D; WT = ws_set + WO_1O; K = FF; N = D; }
        else if ((r -= I2) < I3) { W = a->in[I_WIN] + (size_t)l * D * INC; ks = a->in[I_NM] + l * D; WT = ws_set + WO_IN; K = D; N = INC; }
        else if ((r -= I3) < I4) { W = a->in[I_WOUT] + (size_t)l * D * D; WT = ws_set + WO_OUT; K = D; N = D; }
        else if ((r -= I4) < I1) { W = a->in[I_W2I] + (size_t)l * D * FF2; ks = a->in[I_N2] + l * D; WT = ws_set + WO_2I; K = D; N = FF2; mode = 1; }
        else if ((r -= I1) < I2) { W = a->in[I_W2O] + (size_t)l * FF * D; WT = ws_set + WO_2O; K = FF; N = D; }
        else { r -= I2; const int g = r >> 3; r &= 7; W = a->in[I_PW] + (size_t)(l * 4 + g) * 16384; ns = a->in[I_PS] + l * 512 + g * 128; WT = ws_set + WO_PW + g * 16384; K = 128; N = 128; }
        const int nblk = N / 32, kb = r / nblk, nb = r % nblk, k0 = 64 * kb, n0 = 32 * nb;
        int drow0 = n0;
        if (mode == 1) { if (n0 < FF) drow0 = (n0 / 128) * 256 + (n0 % 128); else { const int j = n0 - FF; drow0 = (j / 128) * 256 + 128 + (j % 128); } }
        conv_item(W, N, ks, ns, WT, K, drow0, k0, n0, scr, lane);
    }
}

typedef short v4i16_t __attribute__((ext_vector_type(4)));
__device__ __forceinline__ bf16x8 tr_frag(const LAS bf16_t* tile, int stride, int s0, int v0, int r, int q) {
    const LAS bf16_t* p0 = tile + (s0 + 8 * q + (r >> 2)) * stride + v0 + 4 * (r & 3);
    const v4i16_t lo = __builtin_amdgcn_ds_read_tr16_b64_v4i16((LAS v4i16_t*)p0);
    const v4i16_t hi = __builtin_amdgcn_ds_read_tr16_b64_v4i16((LAS v4i16_t*)(p0 + 4 * stride));
    return (bf16x8){lo[0], lo[1], lo[2], lo[3], hi[0], hi[1], hi[2], hi[3]};
}

struct ChunkGeo { int b, h, c, L; size_t r0; };
__device__ __forceinline__ int chunk_slot(int wi) { return wi < 1024 ? (wi >> 5) * NCH + 1 + (wi & 31) : (wi - 1024) * NCH; }
__device__ __forceinline__ ChunkGeo chunk_geo(int it) {
    ChunkGeo g; const int bh = it / NCH; g.c = it - bh * NCH; g.b = bh >> 2; g.h = bh & 3;
    const int t0 = g.c == 0 ? 0 : NMETA + 64 * (g.c - 1); g.L = g.c == 0 ? NMETA : 64; g.r0 = (size_t)g.b * TP + t0; return g;
}

__device__ __forceinline__ void hgrn_local_item(int it, const bf16_t* ZB, const float* GB, bf16_t* CS, float* DEC, LAS unsigned char* lds, int tid) {
    const ChunkGeo G = chunk_geo(it);
    const int d = tid & 127, p = tid >> 7, lane = tid & 63, w = tid >> 6, r = lane & 15, q = lane >> 4;
    LAS float* TOT = (LAS float*)lds;
    LAS bf16_t* KDT = (LAS bf16_t*)(lds + 2048);
    LAS bf16_t* VS = (LAS bf16_t*)(lds + 20480);
    const bool pv = (16 * p < G.L);
    float bb[16]; unsigned short kraw[16]; u32x4 vv[2];
    const int prow = pv ? 16 * p : 0;
#pragma unroll
    for (int i = 0; i < 16; ++i) bb[i] = GB[(G.r0 + prow + i) * 512 + G.h * 128 + d];
#pragma unroll
    for (int i = 0; i < 16; ++i) kraw[i] = ZB[(G.r0 + prow + i) * INC + 512 + G.h * 128 + d];
#pragma unroll
    for (int e2 = 0; e2 < 2; ++e2) { const int e = tid + 512 * e2, s = e >> 4, ch = e & 15; const int sc = s < G.L ? s : 0;
        vv[e2] = *(const u32x4*)(ZB + (G.r0 + sc) * INC + 1024 + G.h * 128 + ch * 8); }
#pragma unroll
    for (int i = 0; i < 16; ++i) { bb[i] = pv ? bb[i] : 0.f; kraw[i] = pv ? kraw[i] : (unsigned short)0; }
#pragma unroll
    for (int e2 = 0; e2 < 2; ++e2) { const int e = tid + 512 * e2, s = e >> 4; if (s >= G.L) vv[e2] = (u32x4){0u, 0u, 0u, 0u}; }
    float run = 0.f;
#pragma unroll
    for (int i = 0; i < 16; ++i) { run += bb[i]; bb[i] = run; }
    TOT[p * 128 + d] = run;
#pragma unroll
    for (int e2 = 0; e2 < 2; ++e2) { const int e = tid + 512 * e2, s = e >> 4, ch = e & 15; *(LAS u32x4*)(VS + s * 136 + ch * 8) = vv[e2]; }
    __syncthreads();
    float off = 0.f, tot = 0.f;
#pragma unroll
    for (int pp = 0; pp < 4; ++pp) { const float tv = TOT[pp * 128 + d]; if (pp < p) off += tv; tot += tv; }
    unsigned kd[8];
#pragma unroll
    for (int i = 0; i < 16; i += 2) {
        const float k0 = bf2f(kraw[i]), k1 = bf2f(kraw[i + 1]);
        kd[i >> 1] = cvt_pk_bf16(k0 * __expf(tot - (bb[i] + off)), k1 * __expf(tot - (bb[i + 1] + off)));
    }
    *(LAS u32x4*)(KDT + d * 72 + 16 * p) = (u32x4){kd[0], kd[1], kd[2], kd[3]};
    *(LAS u32x4*)(KDT + d * 72 + 16 * p + 8) = (u32x4){kd[4], kd[5], kd[6], kd[7]};
    if (p == 0) DEC[(size_t)it * 128 + d] = __expf(tot);
    __syncthreads();
    bf16x8 vf[2];
#pragma unroll
    for (int ks = 0; ks < 2; ++ks) vf[ks] = tr_frag(VS, 136, 32 * ks, 16 * w, r, q);
    bf16_t* cs = CS + (size_t)it * 16384;
#pragma unroll
    for (int dt = 0; dt < 8; ++dt) {
        f32x4 acc = (f32x4){0.f, 0.f, 0.f, 0.f};
#pragma unroll
        for (int ks = 0; ks < 2; ++ks) { const bf16x8 kf = *(const LAS bf16x8*)(KDT + (16 * dt + r) * 72 + 32 * ks + 8 * q); acc = __builtin_amdgcn_mfma_f32_16x16x32_bf16(kf, vf[ks], acc, 0, 0, 0); }
        { u32x2 wv; wv.x = cvt_pk_bf16(acc[0], acc[1]); wv.y = cvt_pk_bf16(acc[2], acc[3]); *(u32x2*)(cs + (16 * w + r) * 128 + 16 * dt + 4 * q) = wv; }
    }
    __syncthreads();
}

__device__ __forceinline__ void sample_item(int its, int l, ArgsP a, const bf16_t* ZB, const float* GB, bf16_t* MIX, LAS unsigned char* lds, int tid) {
    const int b = its >> 2, h = its & 3; const size_t row0 = (size_t)MP + 4 * b;
    const int lane = tid & 63, wave = tid >> 6;
    LAS float* QKF = (LAS float*)lds;
    LAS float* VG = (LAS float*)(lds + 6144);
    LAS float* OP = (LAS float*)(lds + 10240);
    LAS float* RS = (LAS float*)(lds + 18432);
    {
        const int t = tid >> 7, d = tid & 127; const bf16_t* zr = ZB + (row0 + t) * INC + h * 128 + d;
        QKF[(0 * 4 + t) * 128 + d] = bf2f(zr[0]); QKF[(1 * 4 + t) * 128 + d] = bf2f(zr[512]);
        QKF[(2 * 4 + t) * 128 + d] = __expf(GB[(row0 + t) * 512 + h * 128 + d]);
        VG[(0 * 4 + t) * 128 + d] = bf2f(zr[1024]); VG[(1 * 4 + t) * 128 + d] = bf2f(zr[1536]);
    }
    const int v = tid & 127, dq = tid >> 7;
    float S[32];
    const size_t sbase = (((size_t)l * DBATCH + b) * NH + h) * 16384 + (size_t)(32 * dq) * 128 + v;
    const float* sp = a->in[I_SHG] + sbase;
#pragma unroll
    for (int i = 0; i < 32; ++i) S[i] = sp[i * 128];
    __syncthreads();
#pragma unroll
    for (int t = 0; t < 4; ++t) {
        const float vt = VG[(0 * 4 + t) * 128 + v]; float acc = 0.f;
        const float fq_ = QKF[(2 * 4 + t) * 128 + 32 * dq + (lane & 31)], kq_ = QKF[(1 * 4 + t) * 128 + 32 * dq + (lane & 31)], qq_ = QKF[(0 * 4 + t) * 128 + 32 * dq + (lane & 31)];
#pragma unroll
        for (int i = 0; i < 32; ++i) {
            const float fi = __builtin_bit_cast(float, __builtin_amdgcn_readlane(__builtin_bit_cast(int, fq_), i));
            const float ki = __builtin_bit_cast(float, __builtin_amdgcn_readlane(__builtin_bit_cast(int, kq_), i));
            const float qi = __builtin_bit_cast(float, __builtin_amdgcn_readlane(__builtin_bit_cast(int, qq_), i));
            S[i] = fi * S[i] + ki * vt; acc += qi * S[i]; }
        OP[(dq * 4 + t) * 128 + v] = acc;
    }
    float* so = a->out + O_HGS + sbase;
#pragma unroll
    for (int i = 0; i < 32; ++i) so[i * 128] = S[i];
    __syncthreads();
    {
        const int t = tid >> 7;
        const float ov = OP[(0 * 4 + t) * 128 + v] + OP[(1 * 4 + t) * 128 + v] + OP[(2 * 4 + t) * 128 + v] + OP[(3 * 4 + t) * 128 + v];
        const float sq = wave_sum(ov * ov);
        if (lane == 0) RS[wave] = sq;
        __syncthreads();
        const float tot = RS[wave & ~1] + RS[wave | 1];
        const float rn = rsqrtf(tot * (1.f / 128.f) + EPS);
        const float o = ov * rn * a->in[I_HGN][l * 512 + h * 128 + v] * VG[(1 * 4 + t) * 128 + v];
        MIX[(row0 + t) * D + h * 128 + v] = (DBG_MASK & 4) ? (bf16_t)0 : (bf16_t)f2bf(o);
    }
    __syncthreads();
}

__device__ __forceinline__ void pool_item(int ip, int l, ArgsP a, const bf16_t* ZB, const bf16_t* PWT, bf16_t* MIX, LAS unsigned char* lds, int tid) {
    const int cc = tid & 127, p = tid >> 7, lane = tid & 63, w8 = tid >> 6, r = lane & 15, q = lane >> 4;
    LAS bf16_t* DA = (LAS bf16_t*)lds;
    float dd[2][16]; int g0, L; size_t rowbase;
    const char* zbb = (const char*)ZB; const char* spb = (const char*)a->in[I_SPOOL]; char* outb = (char*)a->out;
    if (ip < NB * NCH * 2) {
        const int b = ip / (NCH * 2), rem = ip - b * (NCH * 2), c = rem >> 1; g0 = (rem & 1) * 2;
        const int t0 = c == 0 ? 0 : NMETA + 64 * (c - 1); L = c == 0 ? NMETA : 64; rowbase = (size_t)b * TP + t0;
        const bool pv = 16 * p < L;
        float uu[2][31];
#pragma unroll
        for (int gi = 0; gi < 2; ++gi)
#pragma unroll
            for (int j = 0; j < 31; ++j) { const int t = t0 + 16 * p - 15 + j; const int tc = (pv && t >= 0) ? t : 0;
                const unsigned boff = (unsigned)(((b * TP + tc) * INC + 2048 + (g0 + gi) * 128 + cc) * 2);
                uu[gi][j] = bf2f(*(const unsigned short*)(zbb + boff)); }
#pragma unroll
        for (int gi = 0; gi < 2; ++gi) {
            const int g = g0 + gi, w = 2 << g;
#pragma unroll
            for (int j = 0; j < 31; ++j) { const int t = t0 + 16 * p - 15 + j; uu[gi][j] = (pv && t >= 0) ? uu[gi][j] : 0.f; }
#pragma unroll
            for (int i = 0; i < 16; ++i) {
                const int t = t0 + 16 * p + i; float s = 0.f;
#pragma unroll
                for (int j = 0; j < 16; ++j) if (j < w) s += uu[gi][15 + i - j];
                const float cnt = (float)min(w, t + 1);
                dd[gi][i] = pv ? (s / cnt - uu[gi][15 + i]) : 0.f;
                if (c == NCH - 1) { const int jj = t - (TP - PST); if (jj >= 0) *(float*)(outb + (unsigned)((O_POOLP + ((l * NB + b) * PST + jj) * 512 + g * 128 + cc) * 4)) = uu[gi][15 + i]; }
            }
        }
    } else {
        const int is = ip - NB * NCH * 2; const int sb = is >> 1; g0 = (is & 1) * 2; L = 64; rowbase = (size_t)MP + 64 * sb;
#pragma unroll
        for (int gi = 0; gi < 2; ++gi) {
            const int g = g0 + gi, w = 2 << g; const float invw = 1.f / (float)w;
#pragma unroll
            for (int bi = 0; bi < 4; ++bi) {
                const int bb = 16 * sb + 4 * p + bi; float ext[19];
#pragma unroll
                for (int j = 0; j < 15; ++j) ext[j] = *(const float*)(spb + (unsigned)((((l * DBATCH + bb) * PST + j) * 512 + g * 128 + cc) * 4));
#pragma unroll
                for (int t = 0; t < 4; ++t) ext[15 + t] = bf2f(*(const unsigned short*)(zbb + (unsigned)(((MP + 4 * bb + t) * INC + 2048 + g * 128 + cc) * 2)));
#pragma unroll
                for (int t = 0; t < 4; ++t) { float s = 0.f;
#pragma unroll
                    for (int j = 0; j < 16; ++j) if (j < w) s += ext[15 + t - j];
                    dd[gi][4 * bi + t] = s * invw - ext[15 + t]; }
#pragma unroll
                for (int j = 0; j < 15; ++j) *(float*)(outb + (unsigned)((O_POOLS + ((l * DBATCH + bb) * PST + j) * 512 + g * 128 + cc) * 4)) = ext[4 + j];
            }
        }
    }
#pragma unroll
    for (int gi = 0; gi < 2; ++gi)
#pragma unroll
        for (int i = 0; i < 16; ++i) DA[(gi * 64 + 16 * p + i) * 136 + cc] = (bf16_t)f2bf(dd[gi][i]);
    __syncthreads();
#pragma unroll
    for (int gi = 0; gi < 2; ++gi) {
        const int g = g0 + gi;
        bf16x8 bfr[4];
#pragma unroll
        for (int ks = 0; ks < 4; ++ks) bfr[ks] = *(const bf16x8*)(PWT + (size_t)g * 16384 + (16 * w8 + r) * 128 + 32 * ks + 8 * q);
#pragma unroll
        for (int tt = 0; tt < 4; ++tt) {
            f32x4 acc = (f32x4){0.f, 0.f, 0.f, 0.f};
#pragma unroll
            for (int ks = 0; ks < 4; ++ks) { const bf16x8 af = *(const LAS bf16x8*)(DA + (gi * 64 + 16 * tt + r) * 136 + 32 * ks + 8 * q); acc = __builtin_amdgcn_mfma_f32_16x16x32_bf16(bfr[ks], af, acc, 0, 0, 0); }
            if (16 * tt + r < L) { u32x2 wv; wv.x = cvt_pk_bf16(acc[0], acc[1]); wv.y = cvt_pk_bf16(acc[2], acc[3]);
                *(u32x2*)(MIX + (rowbase + 16 * tt + r) * D + 512 + g * 128 + 16 * w8 + 4 * q) = wv; }
        }
    }
    __syncthreads();
}

__device__ __forceinline__ void hgrn_scan(int l, ArgsP a, const bf16_t* CS, bf16_t* SB, const float* DEC, int gt, int ngt) {
    for (int idx = gt; idx < NB * NH * 128 * 32; idx += ngt) {
        const int d4 = idx & 31, v = (idx >> 5) & 127, bh = idx >> 12;
        f32x4 S = (f32x4){0.f, 0.f, 0.f, 0.f};
        const bf16_t* cs = CS + (size_t)bh * NCH * 16384 + v * 128 + 4 * d4; const float* dc = DEC + (size_t)bh * NCH * 128 + 4 * d4;
        bf16_t* sb = SB + (size_t)bh * NCH * 16384 + v * 128 + 4 * d4;
#pragma unroll 1
        for (int c0 = 0; c0 < NCH; c0 += 11) {
            f32x4 loc[11], de[11];
#pragma unroll
            for (int j = 0; j < 11; ++j) { const u32x2 w = *(const u32x2*)(cs + (size_t)(c0 + j) * 16384); de[j] = *(const f32x4*)(dc + (c0 + j) * 128);
                loc[j] = (f32x4){__builtin_bit_cast(float, w.x << 16), __builtin_bit_cast(float, w.x & 0xffff0000u), __builtin_bit_cast(float, w.y << 16), __builtin_bit_cast(float, w.y & 0xffff0000u)}; }
#pragma unroll
            for (int j = 0; j < 11; ++j) {
                u32x2 w; w.x = cvt_pk_bf16(S[0], S[1]); w.y = cvt_pk_bf16(S[2], S[3]);
                *(u32x2*)(sb + (size_t)(c0 + j) * 16384) = w;
                S = de[j] * S + loc[j];
            }
        }
        float* o = a->out + O_HGP + ((size_t)l * NB * NH + bh) * 16384 + (size_t)(4 * d4) * 128 + v;
        o[0] = S[0]; o[128] = S[1]; o[256] = S[2]; o[384] = S[3];
    }
}

__device__ __forceinline__ void hgrn_out_item(int it, int l, ArgsP a, const bf16_t* ZB, const float* GB, const bf16_t* SB, bf16_t* MIX, LAS unsigned char* lds, int tid) {
    const ChunkGeo G = chunk_geo(it);
    const int d = tid & 127, p = tid >> 7, lane = tid & 63, w = tid >> 6, r = lane & 15, q = lane >> 4;
    LAS float* TOT = (LAS float*)lds;
    LAS float* RR = (LAS float*)(lds + 2048);
    LAS float* RS = (LAS float*)(lds + 4096);
    LAS bf16_t* QS = (LAS bf16_t*)(lds + 6144);
    LAS bf16_t* QE = (LAS bf16_t*)(lds + 23552);
    LAS bf16_t* VS = (LAS bf16_t*)(lds + 40960);
    LAS bf16_t* PP = (LAS bf16_t*)(lds + 58368);
    LAS bf16_t* KS = (LAS bf16_t*)(lds + 67584);
    const bool pv = (16 * p < G.L);
    float bb[16]; unsigned short qraw[16], kraw[16]; u32x4 vv[2]; bf16x8 sf[4]; u32x2 graw[4];
    const int prow = pv ? 16 * p : 0;
#pragma unroll
    for (int i = 0; i < 16; ++i) bb[i] = GB[(G.r0 + prow + i) * 512 + G.h * 128 + d];
#pragma unroll
    for (int i = 0; i < 16; ++i) { qraw[i] = ZB[(G.r0 + prow + i) * INC + G.h * 128 + d]; kraw[i] = ZB[(G.r0 + prow + i) * INC + 512 + G.h * 128 + d]; }
#pragma unroll
    for (int e2 = 0; e2 < 2; ++e2) { const int e = tid + 512 * e2, s = e >> 4, ch = e & 15; const int sc = s < G.L ? s : 0;
        vv[e2] = *(const u32x4*)(ZB + (G.r0 + sc) * INC + 1024 + G.h * 128 + ch * 8); }
    {
        const bf16_t* st = SB + (size_t)it * 16384 + (16 * w + r) * 128 + 8 * q;
#pragma unroll
        for (int ks = 0; ks < 4; ++ks) sf[ks] = *(const bf16x8*)(st + 32 * ks);
    }
#pragma unroll
    for (int tt = 0; tt < 4; ++tt) { const int tc = (16 * tt + r < G.L) ? 16 * tt + r : 0; graw[tt] = *(const u32x2*)(ZB + (G.r0 + tc) * INC + 1536 + G.h * 128 + 16 * w + 4 * q); }
#pragma unroll
    for (int i = 0; i < 16; ++i) { bb[i] = pv ? bb[i] : 0.f; qraw[i] = pv ? qraw[i] : (unsigned short)0; kraw[i] = pv ? kraw[i] : (unsigned short)0; }
#pragma unroll
    for (int e2 = 0; e2 < 2; ++e2) { const int e = tid + 512 * e2, s = e >> 4; if (s >= G.L) vv[e2] = (u32x4){0u, 0u, 0u, 0u}; }
    float run = 0.f;
#pragma unroll
    for (int i = 0; i < 16; ++i) { run += bb[i]; bb[i] = run; }
    TOT[p * 128 + d] = run;
#pragma unroll
    for (int e2 = 0; e2 < 2; ++e2) { const int e = tid + 512 * e2, s = e >> 4, ch = e & 15; *(LAS u32x4*)(VS + s * 136 + ch * 8) = vv[e2]; }
    __syncthreads();
    float off = 0.f;
#pragma unroll
    for (int pp = 0; pp < 4; ++pp) { const float tv = TOT[pp * 128 + d]; if (pp < p) off += tv; }
#pragma unroll
    for (int i = 0; i < 16; ++i) bb[i] += off;
    RR[p * 128 + d] = bb[0];
#pragma unroll
    for (int i = 0; i < 16; ++i) {
        const float qv = bf2f(qraw[i]);
        QS[(16 * p + i) * 136 + d] = (bf16_t)f2bf(qv * __expf(bb[i] - bb[0]));
        QE[(16 * p + i) * 136 + d] = (bf16_t)f2bf(qv * __expf(bb[i]));
    }
    float kv[16];
#pragma unroll
    for (int i = 0; i < 16; ++i) kv[i] = bf2f(kraw[i]);
    __syncthreads();
#pragma unroll
    for (int I = 0; I < 4; ++I) {
        if (I >= p) {
            const float ref = RR[I * 128 + d]; const int base = 8 * I * (I + 1);
#pragma unroll
            for (int i = 0; i < 16; ++i) KS[(base + 16 * p + i) * 136 + d] = (bf16_t)f2bf(kv[i] * __expf(ref - bb[i]));
        }
    }
    __syncthreads();
#pragma unroll
    for (int h2 = 0; h2 < 2; ++h2) {
        const int id = w + 8 * h2, I = id >> 2, J = id & 3;
        f32x4 acc = (f32x4){0.f, 0.f, 0.f, 0.f};
        if (J <= I) {
#pragma unroll
            for (int ks = 0; ks < 4; ++ks) {
                const bf16x8 af = *(const LAS bf16x8*)(QS + (16 * I + r) * 136 + 32 * ks + 8 * q);
                const bf16x8 bf = *(const LAS bf16x8*)(KS + (8 * I * (I + 1) + 16 * J + r) * 136 + 32 * ks + 8 * q);
                acc = __builtin_amdgcn_mfma_f32_16x16x32_bf16(af, bf, acc, 0, 0, 0);
            }
        }
#pragma unroll
        for (int j = 0; j < 4; ++j) {
            float sv = acc[j]; if (J > I || (J == I && r > 4 * q + j)) sv = 0.f;
            PP[(16 * I + 4 * q + j) * 72 + 16 * J + r] = (bf16_t)f2bf(sv);
        }
    }
    __syncthreads();
    bf16x8 vf[2];
#pragma unroll
    for (int ks = 0; ks < 2; ++ks) vf[ks] = tr_frag(VS, 136, 32 * ks, 16 * w, r, q);
    f32x4 acc[4];
#pragma unroll
    for (int tt = 0; tt < 4; ++tt) {
        acc[tt] = (f32x4){0.f, 0.f, 0.f, 0.f};
#pragma unroll
        for (int ks = 0; ks < 2; ++ks) { const bf16x8 pf = *(const LAS bf16x8*)(PP + (16 * tt + r) * 72 + 32 * ks + 8 * q); acc[tt] = __builtin_amdgcn_mfma_f32_16x16x32_bf16(vf[ks], pf, acc[tt], 0, 0, 0); }
#pragma unroll
        for (int ks = 0; ks < 4; ++ks) { const bf16x8 qf = *(const LAS bf16x8*)(QE + (16 * tt + r) * 136 + 32 * ks + 8 * q); acc[tt] = __builtin_amdgcn_mfma_f32_16x16x32_bf16(sf[ks], qf, acc[tt], 0, 0, 0); }
        float s = (acc[tt][0] * acc[tt][0] + acc[tt][1] * acc[tt][1]) + (acc[tt][2] * acc[tt][2] + acc[tt][3] * acc[tt][3]);
        s += __shfl_xor(s, 16); s += __shfl_xor(s, 32);
        if (q == 0) RS[w * 64 + 16 * tt + r] = s;
    }
    __syncthreads();
    const f32x4 hgn = *(const f32x4*)(a->in[I_HGN] + l * 512 + G.h * 128 + 16 * w + 4 * q);
#pragma unroll
    for (int tt = 0; tt < 4; ++tt) {
        const int t = 16 * tt + r;
        float tot = 0.f;
#pragma unroll
        for (int ww = 0; ww < 8; ++ww) tot += RS[ww * 64 + t];
        const float rn = rsqrtf(tot * (1.f / 128.f) + EPS);
        if (t < G.L) {
            const size_t row = G.r0 + t;
            const u32x2 gt2 = graw[tt];
            const float g0 = bf2f((unsigned short)(gt2.x & 0xffffu)), g1 = bf2f((unsigned short)(gt2.x >> 16)), g2 = bf2f((unsigned short)(gt2.y & 0xffffu)), g3 = bf2f((unsigned short)(gt2.y >> 16));
            u32x2 wv; wv.x = cvt_pk_bf16(acc[tt][0] * rn * hgn[0] * g0, acc[tt][1] * rn * hgn[1] * g1); wv.y = cvt_pk_bf16(acc[tt][2] * rn * hgn[2] * g2, acc[tt][3] * rn * hgn[3] * g3);
            if (DBG_MASK & 1) wv = (u32x2){0u, 0u};
            *(u32x2*)(MIX + row * D + G.h * 128 + 16 * w + 4 * q) = wv;
        }
    }
    __syncthreads();
}

__device__ __forceinline__ void final_rows(ArgsP a, const bf16_t* XB, int m0, int m_end, int step, int lane) {
    const float* nf = a->in[I_NF]; float* outp = a->out;
    for (int m = m0; m < m_end; m += step) {
        float* o;
        if (m < MP) { const int b = m / TP, t = m - b * TP; if (t < NMETA) continue; o = outp + O_YP + ((size_t)b * SEQ + (t - NMETA)) * D; }
        else o = outp + O_YS + (size_t)(m - MP) * D;
        f32x4 x[4]; float s = 0.f;
#pragma unroll
        for (int j = 0; j < 4; ++j) { const u32x2 w = ((const u32x2*)(XB + (size_t)m * D))[lane + 64 * j];
            x[j] = (f32x4){__builtin_bit_cast(float, w.x << 16), __builtin_bit_cast(float, w.x & 0xffff0000u), __builtin_bit_cast(float, w.y << 16), __builtin_bit_cast(float, w.y & 0xffff0000u)};
            s += (x[j][0] * x[j][0] + x[j][1] * x[j][1]) + (x[j][2] * x[j][2] + x[j][3] * x[j][3]); }
        const float rstd = rsqrtf(wave_sum(s) * (1.f / D) + EPS);
#pragma unroll
        for (int j = 0; j < 4; ++j) { const f32x4 gn = ((const f32x4*)nf)[lane + 64 * j]; ((f32x4*)o)[lane + 64 * j] = x[j] * rstd * gn; }
    }
}

__global__ void __launch_bounds__(512, 2) mk_fwd(Args a_) {
    __shared__ __attribute__((aligned(16))) unsigned char lds_raw[LDS_BYTES];
    LAS unsigned char* lds = (LAS unsigned char*)lds_raw;
    const int ph_lo = a_.ph_lo, ph_hi = a_.ph_hi;
    volatile LAS unsigned* bst = (volatile LAS unsigned*)(lds + LDS_BYTES - 64);
    XcdBarrier bar; bar.bar = (unsigned*)(a_.ws + WS_CTL); bar.x = 0; bar.st = bst;
    if (ph_hi - ph_lo > 1) {
        if (threadIdx.x < 16) bst[threadIdx.x] = 0u;
        __syncthreads();
        bar = xcd_barrier_post((unsigned*)(a_.ws + WS_CTL), bst);
    }

    for (int ph = ph_lo; ph < ph_hi; ++ph) {
        ArgsP a = (ArgsP)__builtin_amdgcn_kernarg_segment_ptr();
        asm volatile("" : "+s"(a));
        int tid = threadIdx.x; asm volatile("" : "+v"(tid));
        const int lane = tid & 63, wave = __builtin_amdgcn_readfirstlane(tid >> 6);
        const int G = gridDim.x, bx = blockIdx.x;
        const int gw = bx * 8 + wave, NGW = G * 8;
        unsigned char* ws = a->ws;
        float* SS = (float*)(ws + WS_SS);
        float* LB = (float*)(ws + WS_LB);
        float* DEC = (float*)(ws + WS_DEC);
        float* X = (float*)(ws + WS_X);
        bf16_t* XB = (bf16_t*)(ws + WS_XB);
        bf16_t* MIX = (bf16_t*)(ws + WS_MIX);
        bf16_t* HB = (bf16_t*)(ws + WS_HZ);
        bf16_t* ZB = (bf16_t*)(ws + WS_HZ);
        float* GB = (float*)(ws + WS_HZ + (size_t)MPAD * INC * 2);
        bf16_t* CS = (bf16_t*)(ws + WS_CS);
        LAS float* scr = (LAS float*)(lds + wave * 8448);
        if (ph == 0) {
            for (int m = gw; m < MPAD; m += NGW) {
                const float* src = a->in[I_META];
                if (m < MP) { const int b = m / TP, t = m - b * TP; src = t < NMETA ? a->in[I_META] + (size_t)t * D : a->in[I_XP] + ((size_t)b * SEQ + (t - NMETA)) * D; }
                else if (m < MT) src = a->in[I_XS] + (size_t)(m - MP) * D;
                f32x4 v[4]; float s = 0.f;
#pragma unroll
                for (int j = 0; j < 4; ++j) v[j] = ((const f32x4*)src)[lane + 64 * j];
#pragma unroll
                for (int j = 0; j < 4; ++j) { if (m >= MT) v[j] = (f32x4){0.f, 0.f, 0.f, 0.f}; s += (v[j][0] * v[j][0] + v[j][1] * v[j][1]) + (v[j][2] * v[j][2] + v[j][3] * v[j][3]); }
                s = wave_sum(s);
#pragma unroll
                for (int j = 0; j < 4; ++j) {
                    u32x2 wv; wv.x = cvt_pk_bf16(v[j][0], v[j][1]); wv.y = cvt_pk_bf16(v[j][2], v[j][3]);
                    ((u32x2*)(XB + (size_t)m * D))[lane + 64 * j] = wv;
                    if (m >= MT) ((u32x2*)(MIX + (size_t)m * D))[lane + 64 * j] = (u32x2){0u, 0u};
                }
                if (lane < 16) SS[(size_t)m * 16 + lane] = lane == 0 ? s : 0.f;
            }
            {
                const int c = bx * 512 + tid;
                if (c < 512) {
                    float lg[4], mx = -1e30f;
#pragma unroll
                    for (int i = 0; i < 4; ++i) { lg[i] = a->in[I_LBL][i * 512 + c]; mx = fmaxf(mx, lg[i]); }
                    float sum = 0.f;
#pragma unroll
                    for (int i = 0; i < 4; ++i) { lg[i] = expf(lg[i] - mx); sum += lg[i]; }
                    const float inv = 1.f / sum; float cum = 0.f;
                    LB[c] = 0.f;
#pragma unroll
                    for (int i = 1; i < 4; ++i) { cum += lg[i] * inv; LB[i * 512 + c] = cum; }
                }
            }
            wconv_layer(a, 0, (bf16_t*)(ws + WS_W), scr, gw, NGW, lane);
            __syncthreads();
        } else {
            const int l = (ph - 1) / NK, k = KSEQ[(ph - 1) % NK];
            bf16_t* wset = (bf16_t*)(ws + WS_W + (size_t)(l & 1) * WSET_BYTES);
            bf16_t* wprev = (bf16_t*)(ws + WS_W + (size_t)((l + 1) & 1) * WSET_BYTES);
            bf16_t* HSv = (bf16_t*)(ws + WS_HS) - (size_t)MMAIN * FF;
            unsigned* cnts = (unsigned*)(ws + WS_CTL) + 4096;
            if (k == 3) {
                constexpr int NPI = NB * NCH * 2 + 16;
                constexpr int NIT = NHI + 512 + NPI; const int nrounds = (NIT + G - 1) / G;
                for (int k2 = 0; k2 < nrounds; ++k2) {
                    const int it = bx + ((k2 + bx) % nrounds) * G; if (it >= NIT) continue;
                    int t2 = tid; asm volatile("" : "+v"(t2));
                    if (it < NHI) hgrn_local_item(chunk_slot(it), ZB, GB, CS, DEC, lds, t2);
                    else if (it < NHI + 512) sample_item(it - NHI, l, a, ZB, GB, MIX, lds, t2);
                    else pool_item(it - NHI - 512, l, a, ZB, wset + WO_PW, MIX, lds, t2);
                }
            } else if (k == 4) {
                hgrn_scan(l, a, CS, (bf16_t*)(ws + WS_SB), DEC, bx * 512 + tid, G * 512);
                if (l + 1 < DEPTH) wconv_layer(a, l + 1, (bf16_t*)(ws + WS_W + (size_t)((l + 1) & 1) * WSET_BYTES), scr, gw, NGW, lane);
                __syncthreads();
            } else if (k == 5) {
                for (int it = bx; it < NHI; it += G) hgrn_out_item(chunk_slot(it), l, a, ZB, GB, (const bf16_t*)(ws + WS_SB), MIX, lds, tid);
            } else {
                const bool lastph = (ph == NPH - 1);
                const bool split = (k == 2) || lastph;
                const int nded = split ? 24 : NDED;
                {
                    const bool full = (k == 1 || k == 6 || k == 8);
                    const bool prod = !full && bx < (split ? 24 : NPROD) && !(k == 0 && l == 0);
                    if (full || prod) {
                        const int kk = full ? k : (k == 2 ? 1 : (k == 7 ? 6 : 8));
                        const bf16_t* wr_set = (k == 0) ? wprev : wset;
                        const int Kk = kk == 6 ? D : FF;
                        pg8::Gemm g = pg8::mk_gemm(full ? (kk == 6 ? MIX : HB) : (kk == 6 ? MIX : HSv), wr_set + (kk == 1 ? WO_1O : (kk == 8 ? WO_2O : WO_OUT)), MPAD, D, Kk);
                        pg8::Order S; int mode = 0; unsigned* pc = cnts + 64 * (12 + l * 12 + (bx >> 1));
                        if (full) S.init_static(MMAIN, D, G, bx);
                        else if (split) { S.init_list(4, bx >> 1, 0, 1); g.nt = Kk / 128; g.koff = (bx & 1) * (Kk / 2) * 2; mode = 1 + (bx & 1); }
                        else S.init_list(4, bx, 0, 1);
                        pg8::EpiResid E{X, XB, SS, kk == 6 ? 1.0f : 0.5f, mode, pc};
                        pg8::gemm_phase<pg8::EpiResid, pg8::Order, true, true>(lds, g, S, E, tid);
                        if (prod) handoff_publish(mode == 1 ? pc : cnts + 64 * ((k == 0 ? (l - 1) * 3 + 2 : l * 3 + (k == 2 ? 0 : 1))));
                    }
                }
                if (lastph) {
                    if (bx >= nded) {
                        final_rows(a, XB, (bx - nded) * 8 + wave, MMAIN, (G - nded) * 8, lane);
                        handoff_wait(cnts + 64 * 11, NPROD);
                        final_rows(a, XB, MMAIN + (bx - nded) * 8 + wave, MT, (G - nded) * 8, lane);
                    }
                } else if (k == 0 || k == 7) {
#pragma unroll 1
                    for (int pass = 0; pass < 2; ++pass) {
                        pg8::Gemm g = pg8::mk_gemm(XB, wset + (k == 0 ? WO_1I : WO_2I), MPAD, FF2, D); pg8::Order S; pg8::EpiSwiGLU E{pass ? HSv : HB, SS};
                        if (pass == 0) { if (bx < NDED) continue; S.init_static(MMAIN, FF2, G - NDED, bx - NDED); }
                        else {
                            if (k == 0 && l == 0) { if (bx < NDED) S.init_list(22, bx, NDED, bx < 2 ? 5 : 4); else break; }
                            else if (k == 0) { if (bx < NPROD) S.init_list(22, bx, NPROD, 3); else if (bx < NDED) S.init_list(22, 36 + (bx - NPROD), 4, 3); else if (bx >= G - 18) S.init_list(22, 48 + (bx - (G - 18)), 0, 1); else break; }
                            else { if (bx < NPROD) S.init_list(22, bx, NPROD, 4); else if (bx < NDED) S.init_list(22, 48 + (bx - NPROD), 4, bx - NPROD < 2 ? 5 : 4); else break; }
                            if (!(k == 0 && l == 0)) handoff_wait(cnts + 64 * (k == 0 ? (l - 1) * 3 + 2 : l * 3 + 1), NPROD);
                        }
                        pg8::gemm_phase<pg8::EpiSwiGLU, pg8::Order, true, true>(lds, g, S, E, tid);
                    }
                } else if (k == 2) {
#pragma unroll 1
                    for (int pass = 0; pass < 2; ++pass) {
                        pg8::Gemm g = pg8::mk_gemm(XB, wset + WO_IN, MPAD, INC, D); pg8::Order S; pg8::EpiMix E{ZB, GB, SS, LB + l * 512};
                        if (pass == 0) { if (bx < nded) continue; S.init_static(MMAIN, INC, G - nded, bx - nded); }
                        else {
                            if (bx < nded) S.init_list(10, bx, 0, 1); else if (bx >= G - 6) S.init_list(10, 24 + (bx - (G - 6)), 0, 1); else break;
                            handoff_wait(cnts + 64 * (l * 3 + 0), NPROD);
                        }
                        pg8::gemm_phase<pg8::EpiMix, pg8::Order, true, true>(lds, g, S, E, tid);
                    }
                }
            }
        }
        if (ph + 1 < ph_hi) {
            if (ph_hi == -12345) cg::this_grid().sync();
            xcd_barrier(bar);
        }
    }
}

extern "C" void kernel_launch(void* const* d_in, const int* in_sizes, int n_in, void* d_out, int out_size, void* d_ws, size_t ws_size, hipStream_t stream) {
    static int grid = 0;
    if (grid == 0) {
        if (n_in != 19 || ws_size < WS_END) { fprintf(stderr, "kernel_launch: unexpected inputs (n_in %d, ws %zu < %zu)\n", n_in, ws_size, (size_t)WS_END); grid = -1; return; }
        int dev = 0, cus = 0, per_cu = 0;
        (void)hipGetDevice(&dev);
        (void)hipDeviceGetAttribute(&cus, hipDeviceAttributeMultiprocessorCount, dev);
        (void)hipOccupancyMaxActiveBlocksPerMultiprocessor(&per_cu, (const void*)mk_fwd, 512, 0);
        if (per_cu < 1) per_cu = 1;
        (void)hipGetLastError();
        grid = cus * 1;
    }
    if (grid < 0) return;
    (void)hipMemsetAsync((char*)d_ws, 0, ZERO_BYTES, stream);
    Args a{};
    for (int i = 0; i < 19; ++i) a.in[i] = (const float*)d_in[i];
    a.out = (float*)d_out; a.ws = (unsigned char*)d_ws;
#if ONE_LAUNCH
    a.ph_lo = 0; a.ph_hi = NPH;
    void* args[] = {&a};
    hipError_t e = hipLaunchCooperativeKernel((const void*)mk_fwd, dim3(grid), dim3(512), args, 0, stream);
    if (e != hipSuccess) fprintf(stderr, "cooperative launch failed: %s (grid %d)\n", hipGetErrorString(e), grid);
#else
    for (int ph = 0; ph < NPH; ++ph) {
        if (ph >= DBG_NPH && ph != NPH - 1) continue;
        a.ph_lo = ph; a.ph_hi = ph + 1;
        hipLaunchKernelGGL(mk_fwd, dim3(grid), dim3(512), 0, stream, a);
    }
#endif
}
```
